# Optimizing an MI355X kernel written in HIP

```python
import math
import jax
import jax.numpy as jnp
from jax import lax
import numpy as np

D_MODEL = 1024
BATCH = 8
SEQ = 2048
DEPTH = 2

CTX_LEN = 256
GRID_W = 64
MIX_WIDTH = D_MODEL
BRANCH_WIDTH = MIX_WIDTH // 4
DA_HEADS = 4
DA_VDIM = BRANCH_WIDTH // DA_HEADS
DA_QK = DA_VDIM // 2
HG_HEADS = 4
HG_DK = BRANCH_WIDTH // HG_HEADS
HG_DV = BRANCH_WIDTH // HG_HEADS
HG_CHUNK = 16
SW_HEADS = 4
SW_KV_HEADS = 2
SW_HD = BRANCH_WIDTH // SW_HEADS
SW_WINDOW = 128
SW_BLOCK = 128
ML_HEADS = 4
ML_HD = BRANCH_WIDTH // ML_HEADS
ML_CHUNK = 64

ATTN_QBLOCK = 128
ROPE_BASE = 10000.0
NORM_EPS = 1e-6
F32 = jnp.float32

PROJ_SIZES = (
    DA_HEADS * DA_VDIM, DA_HEADS * DA_VDIM, DA_HEADS * DA_VDIM,
    HG_HEADS * HG_DK, HG_HEADS * HG_DK, HG_HEADS * HG_DK, HG_HEADS * HG_DV,
    SW_HEADS * SW_HD, SW_KV_HEADS * SW_HD, SW_KV_HEADS * SW_HD,
    ML_HEADS * ML_HD, ML_HEADS * ML_HD, ML_HEADS * ML_HD,
    ML_HEADS, ML_HEADS, ML_HEADS, ML_HEADS,
    ML_HEADS * ML_HD,
    MIX_WIDTH,
)
PROJ_WIDTH = sum(PROJ_SIZES)

kernel_name = "hybrid_parallel_diffattn_hgrn2_swa_mlstm"


def rmsnorm(x, g):
    xf = x.astype(F32)
    y = xf * lax.rsqrt(jnp.mean(xf * xf, axis=-1, keepdims=True) + NORM_EPS)
    return (y * g.astype(F32)).astype(x.dtype)


def to_heads(t, n_heads):
    b, n, w = t.shape
    return t.reshape(b, n, n_heads, w // n_heads).transpose(0, 2, 1, 3)


def from_heads(t):
    b, h, n, d = t.shape
    return t.transpose(0, 2, 1, 3).reshape(b, n, h * d)


def flip_time(t):
    return jnp.flip(t, axis=2)


def split_proj(p):
    return jnp.split(p, np.cumsum(PROJ_SIZES)[:-1].tolist(), axis=-1)


def axial_rope_tables(n_tok, dim):
    rows = n_tok // GRID_W
    row = jnp.repeat(jnp.arange(rows, dtype=F32), GRID_W)
    col = jnp.tile(jnp.arange(GRID_W, dtype=F32), rows)
    half = dim // 2
    inv = ROPE_BASE ** (-jnp.arange(0, half, 2, dtype=F32) / half)
    ar = row[:, None] * inv
    ac = col[:, None] * inv
    return (jnp.cos(ar), jnp.sin(ar), jnp.cos(ac), jnp.sin(ac))


def rope2d(x, tabs):
    cr, sr, cc, sc = [t.astype(x.dtype) for t in tabs]
    x1, x2, x3, x4 = jnp.split(x, 4, axis=-1)
    return jnp.concatenate([x1 * cr - x2 * sr, x2 * cr + x1 * sr,
                            x3 * cc - x4 * sc, x4 * cc + x3 * sc], axis=-1)


def diff_attention(qa, ka, va, qc, kc, vc, lam_p, g, layer_idx, tabs, need_ctx_out):
    b, n_tok, _ = qa.shape
    lam_init = 0.8 - 0.6 * math.exp(-0.3 * layer_idx)
    lp = lam_p.astype(F32)
    lam = jnp.exp(jnp.sum(lp[0] * lp[1])) - jnp.exp(jnp.sum(lp[2] * lp[3])) + lam_init
    scale = DA_QK ** -0.5

    def maps(t):
        return t.reshape(t.shape[0], t.shape[1], DA_HEADS, 2, DA_QK).transpose(3, 0, 2, 1, 4)

    q = rope2d(maps(qa), tabs)
    k = rope2d(maps(ka), tabs)
    q_c, k_c = maps(qc), maps(kc)
    v, v_c = to_heads(va, DA_HEADS), to_heads(vc, DA_HEADS)
    keys = jnp.concatenate([k, k_c], axis=3)
    vals = jnp.concatenate([v, v_c], axis=2)

    def attend(qs, ks, vs):
        s = jnp.einsum('mbhqd,mbhkd->mbhqk', qs, ks).astype(F32) * scale
        p = jax.nn.softmax(s, axis=-1)
        w = (p[0] - lam * p[1]).astype(vs.dtype)
        return jnp.einsum('bhqk,bhkv->bhqv', w, vs)

    nb = n_tok // ATTN_QBLOCK
    qb = jnp.moveaxis(q.reshape(2, b, DA_HEADS, nb, ATTN_QBLOCK, DA_QK), 3, 0)
    o = lax.map(lambda qq: attend(qq, keys, vals), qb)
    o = jnp.moveaxis(o, 0, 2).reshape(b, DA_HEADS, n_tok, DA_VDIM)
    y = from_heads(rmsnorm(o, g) * (1.0 - lam_init))
    yc = None
    if need_ctx_out:
        yc = from_heads(rmsnorm(attend(q_c, k_c, v_c), g) * (1.0 - lam_init))
    return y, yc


def hgrn_gates(z, lb):
    z = z.astype(F32)
    log_f = jnp.logaddexp(jnp.log(lb), jnp.log1p(-lb) + jax.nn.log_sigmoid(z))
    k = (1.0 - lb) * jax.nn.sigmoid(-z)
    return log_f, k


def gla_chunked(q, k, v, log_f, s0, chunk, with_output):
    b, h, n_tok, dk = q.shape
    dv = v.shape[-1]
    nc = n_tok // chunk
    q, k, log_f = [t.reshape(b, h, nc, chunk, dk) for t in (q, k, log_f)]
    v = v.reshape(b, h, nc, chunk, dv)
    cum = jnp.cumsum(log_f, axis=3)
    cum_last = cum[:, :, :, -1]
    k_end = k * jnp.exp(cum_last[:, :, :, None] - cum)
    ds = jnp.einsum('bhnlk,bhnlv->bhnkv', k_end, v)

    def step(s, inp):
        ds_j, g_j = inp
        return jnp.exp(g_j)[..., None] * s + ds_j, s

    s_fin, s_start = lax.scan(step, s0, (jnp.moveaxis(ds, 2, 0), jnp.moveaxis(cum_last, 2, 0)))
    if not with_output:
        return None, s_fin
    s_start = jnp.moveaxis(s_start, 0, 2)
    tri = jnp.tril(jnp.ones((chunk, chunk), dtype=bool))
    diff = cum[:, :, :, :, None, :] - cum[:, :, :, None, :, :]
    decay = jnp.exp(jnp.where(tri[:, :, None], diff, -jnp.inf))
    a = jnp.einsum('bhnlk,bhnsk,bhnlsk->bhnls', q, k, decay)
    o = (jnp.einsum('bhnls,bhnsv->bhnlv', a, v)
         + jnp.einsum('bhnlk,bhnkv->bhnlv', q * jnp.exp(cum), s_start))
    return o.reshape(b, h, n_tok, dv), s_fin


def hgrn2_mixer(p_lat, p_ctx, lb, g, need_ctx_out):
    lb_h = lb.reshape(1, HG_HEADS, 1, HG_DK)

    def prep(parts):
        q, ff, fb, i = parts
        q = to_heads(q, HG_HEADS).astype(F32) * HG_DK ** -0.5
        i = to_heads(i, HG_HEADS).astype(F32)
        return q, i, hgrn_gates(to_heads(ff, HG_HEADS), lb_h), hgrn_gates(to_heads(fb, HG_HEADS), lb_h)

    q, i, (lf_f, k_f), (lf_b, k_b) = prep(p_lat)
    qc, ic, (lfc_f, kc_f), (lfc_b, kc_b) = prep(p_ctx)
    s0 = jnp.zeros((q.shape[0], HG_HEADS, HG_DK, HG_DV), F32)
    oc_f, s_f = gla_chunked(qc, kc_f, ic, lfc_f, s0, HG_CHUNK, need_ctx_out)
    oc_b, s_b = gla_chunked(flip_time(qc), flip_time(kc_b), flip_time(ic), flip_time(lfc_b),
                            s0, HG_CHUNK, need_ctx_out)
    o_f, _ = gla_chunked(q, k_f, i, lf_f, s_f, HG_CHUNK, True)
    o_b, _ = gla_chunked(flip_time(q), flip_time(k_b), flip_time(i), flip_time(lf_b),
                         s_b, HG_CHUNK, True)
    dt = p_lat[0].dtype
    y = from_heads(rmsnorm(o_f + flip_time(o_b), g)).astype(dt)
    yc = None
    if need_ctx_out:
        yc = from_heads(rmsnorm(oc_f + flip_time(oc_b), g)).astype(dt)
    return y, yc


def window_gqa(qa, ka, va, qc, kc, vc, sink, tabs, need_ctx_out):
    b, n_tok, _ = qa.shape
    n_ctx = qc.shape[1]
    grp = SW_HEADS // SW_KV_HEADS
    scale = SW_HD ** -0.5

    def qheads(t):
        return t.reshape(b, t.shape[1], SW_KV_HEADS, grp, SW_HD).transpose(0, 2, 3, 1, 4)

    q = rope2d(qheads(qa), tabs)
    k = rope2d(to_heads(ka, SW_KV_HEADS), tabs)
    v = to_heads(va, SW_KV_HEADS)
    q_c, k_c, v_c = qheads(qc), to_heads(kc, SW_KV_HEADS), to_heads(vc, SW_KV_HEADS)
    blk = SW_BLOCK
    nb = n_tok // blk

    def band(t):
        tp = jnp.pad(t, ((0, 0), (0, 0), (blk, blk), (0, 0))).reshape(b, SW_KV_HEADS, nb + 2, blk, SW_HD)
        return jnp.concatenate([tp[:, :, :-2], tp[:, :, 1:-1], tp[:, :, 2:]], axis=3)

    kb, vb = band(k), band(v)
    qb = q.reshape(b, SW_KV_HEADS, grp, nb, blk, SW_HD)
    s_band = jnp.einsum('bkgnqd,bknsd->bkgnqs', qb, kb).astype(F32) * scale
    s_ctx = jnp.einsum('bkgnqd,bkcd->bkgnqc', qb, k_c).astype(F32) * scale
    qpos = jnp.arange(nb)[:, None, None] * blk + jnp.arange(blk)[None, :, None]
    kpos = jnp.arange(nb)[:, None, None] * blk + jnp.arange(3 * blk)[None, None, :] - blk
    valid = (jnp.abs(qpos - kpos) <= SW_WINDOW) & (kpos >= 0) & (kpos < n_tok)
    s_band = jnp.where(valid, s_band, -jnp.inf)
    sink_f = sink.astype(F32)
    sink_l = jnp.broadcast_to(sink_f.reshape(1, SW_KV_HEADS, grp, 1, 1, 1), s_band.shape[:-1] + (1,))
    p = jax.nn.softmax(jnp.concatenate([sink_l, s_ctx, s_band], axis=-1), axis=-1)
    p_ctx = p[..., 1:1 + n_ctx].astype(v.dtype)
    p_band = p[..., 1 + n_ctx:].astype(v.dtype)
    o = (jnp.einsum('bkgnqc,bkcd->bkgnqd', p_ctx, v_c)
         + jnp.einsum('bkgnqs,bknsd->bkgnqd', p_band, vb))
    y = o.reshape(b, SW_KV_HEADS, grp, n_tok, SW_HD).transpose(0, 3, 1, 2, 4).reshape(b, n_tok, SW_HEADS * SW_HD)
    yc = None
    if need_ctx_out:
        s_c = jnp.einsum('bkgqd,bkcd->bkgqc', q_c, k_c).astype(F32) * scale
        sink_c = jnp.broadcast_to(sink_f.reshape(1, SW_KV_HEADS, grp, 1, 1), s_c.shape[:-1] + (1,))
        pc = jax.nn.softmax(jnp.concatenate([sink_c, s_c], axis=-1), axis=-1)[..., 1:].astype(v.dtype)
        oc = jnp.einsum('bkgqc,bkcd->bkgqd', pc, v_c)
        yc = oc.transpose(0, 3, 1, 2, 4).reshape(b, n_ctx, SW_HEADS * SW_HD)
    return y, yc


def mlstm_chunked(q, k, v, ig, lf, state, chunk, with_output):
    b, h, n_tok, d = q.shape
    nc = n_tok // chunk
    q, k, v = [t.reshape(b, h, nc, chunk, d) for t in (q, k, v)]
    ig, lf = [t.reshape(b, h, nc, chunk) for t in (ig, lf)]
    cum = jnp.cumsum(lf, axis=-1)
    cum_last = cum[..., -1]
    a = cum_last[..., None] - cum + ig
    m_loc = jnp.max(a, axis=-1)
    w = jnp.exp(a - m_loc[..., None])
    d_c = jnp.einsum('bhnl,bhnlk,bhnlv->bhnkv', w, k, v)
    d_n = jnp.einsum('bhnl,bhnlk->bhnk', w, k)

    def step(carry, inp):
        c_s, n_s, m_s = carry
        dc_j, dn_j, ml_j, cl_j = inp
        m_new = jnp.maximum(cl_j + m_s, ml_j)
        sp = jnp.exp(cl_j + m_s - m_new)
        sl = jnp.exp(ml_j - m_new)
        c_new = sp[..., None, None] * c_s + sl[..., None, None] * dc_j
        n_new = sp[..., None] * n_s + sl[..., None] * dn_j
        return (c_new, n_new, m_new), (c_s, n_s, m_s)

    final, starts = lax.scan(step, state, (jnp.moveaxis(d_c, 2, 0), jnp.moveaxis(d_n, 2, 0),
                                           jnp.moveaxis(m_loc, 2, 0), jnp.moveaxis(cum_last, 2, 0)))
    if not with_output:
        return None, final
    c0, n0, m0 = [jnp.moveaxis(t, 0, 2) for t in starts]
    tri = jnp.tril(jnp.ones((chunk, chunk), dtype=bool))
    logd = jnp.where(tri, cum[..., :, None] - cum[..., None, :] + ig[..., None, :], -jnp.inf)
    inter = cum + m0[..., None]
    m_t = jnp.maximum(jnp.max(logd, axis=-1), inter)
    dmat = jnp.exp(logd - m_t[..., None])
    g0 = jnp.exp(inter - m_t)
    s = jnp.einsum('bhnld,bhnsd->bhnls', q, k) * dmat
    num = (jnp.einsum('bhnls,bhnsv->bhnlv', s, v)
           + g0[..., None] * jnp.einsum('bhnlk,bhnkv->bhnlv', q, c0))
    den = jnp.sum(s, axis=-1) + g0 * jnp.einsum('bhnlk,bhnk->bhnl', q, n0)
    hid = num / jnp.maximum(jnp.abs(den), jnp.exp(-m_t))[..., None]
    return hid.reshape(b, h, n_tok, d), final


def mlstm_mixer(p_lat, p_ctx, g, need_ctx_out):
    def prep(parts):
        q, k, v, ig_f, ig_b, fg_f, fg_b, og = parts
        q = to_heads(q, ML_HEADS).astype(F32)
        k = to_heads(k, ML_HEADS).astype(F32) * ML_HD ** -0.5
        v = to_heads(v, ML_HEADS).astype(F32)
        tg = lambda t: jnp.swapaxes(t.astype(F32), 1, 2)
        return (q, k, v, tg(ig_f), tg(ig_b),
                jax.nn.log_sigmoid(tg(fg_f)), jax.nn.log_sigmoid(tg(fg_b)), og)

    q, k, v, ig_f, ig_b, lf_f, lf_b, og = prep(p_lat)
    qc, kc, vc, igc_f, igc_b, lfc_f, lfc_b, ogc = prep(p_ctx)
    bsz = q.shape[0]
    st0 = (jnp.zeros((bsz, ML_HEADS, ML_HD, ML_HD), F32),
           jnp.zeros((bsz, ML_HEADS, ML_HD), F32),
           jnp.zeros((bsz, ML_HEADS), F32))
    hc_f, st_f = mlstm_chunked(qc, kc, vc, igc_f, lfc_f, st0, ML_CHUNK, need_ctx_out)
    hc_b, st_b = mlstm_chunked(flip_time(qc), flip_time(kc), flip_time(vc), flip_time(igc_b),
                               flip_time(lfc_b), st0, ML_CHUNK, need_ctx_out)
    h_f, _ = mlstm_chunked(q, k, v, ig_f, lf_f, st_f, ML_CHUNK, True)
    h_b, _ = mlstm_chunked(flip_time(q), flip_time(k), flip_time(v), flip_time(ig_b),
                           flip_time(lf_b), st_b, ML_CHUNK, True)
    y = (from_heads(rmsnorm(h_f + flip_time(h_b), g)) * jax.nn.sigmoid(og.astype(F32))).astype(og.dtype)
    yc = None
    if need_ctx_out:
        yc = (from_heads(rmsnorm(hc_f + flip_time(hc_b), g)) * jax.nn.sigmoid(ogc.astype(F32))).astype(ogc.dtype)
    return y, yc


def hybrid_layer(x, ctx, c, c_ctx, w_mod, b_mod, norm_g, w_in, b_in, diff_lam, diff_g,
                 lb, hg_g, sw_sink, ml_g, w_out, layer_idx, tabs_a, tabs_c, need_ctx_out):
    shift, scale, gate = jnp.split(jax.nn.silu(c) @ w_mod + b_mod, 3, axis=-1)
    shift_c, scale_c, gate_c = jnp.split(jax.nn.silu(c_ctx) @ w_mod + b_mod, 3, axis=-1)
    h = rmsnorm(x, norm_g) * (1.0 + scale[:, None]) + shift[:, None]
    hc = rmsnorm(ctx, norm_g) * (1.0 + scale_c) + shift_c
    p = split_proj(h @ w_in + b_in)
    pc = split_proj(hc @ w_in + b_in)
    ya, ya_c = diff_attention(*p[0:3], *pc[0:3], diff_lam, diff_g, layer_idx, tabs_a, need_ctx_out)
    yb, yb_c = hgrn2_mixer(p[3:7], pc[3:7], lb, hg_g, need_ctx_out)
    yc, yc_c = window_gqa(*p[7:10], *pc[7:10], sw_sink, tabs_c, need_ctx_out)
    yd, yd_c = mlstm_mixer(p[10:18], pc[10:18], ml_g, need_ctx_out)
    mixed = jnp.concatenate([ya, yb, yc, yd], axis=-1) * jax.nn.silu(p[18])
    x = x + gate[:, None] * (mixed @ w_out)
    if need_ctx_out:
        mixed_c = jnp.concatenate([ya_c, yb_c, yc_c, yd_c], axis=-1) * jax.nn.silu(pc[18])
        ctx = ctx + gate_c * (mixed_c @ w_out)
    return x, ctx


def setup_inputs(seed: int = 0) -> dict:
    key = jax.random.key(seed)
    ks = jax.random.split(key, 18)
    nrm = jax.random.normal
    d = D_MODEL
    return {
        "x": nrm(ks[0], (BATCH, SEQ, d), F32),
        "c": nrm(ks[1], (BATCH, d), F32),
        "ctx": nrm(ks[2], (BATCH, CTX_LEN, d), F32),
        "c_ctx": nrm(ks[3], (d,), F32),
        "w_mod": nrm(ks[4], (DEPTH, d, 3 * d), F32) * (0.5 * d ** -0.5),
        "b_mod": nrm(ks[5], (DEPTH, 3 * d), F32) * 0.02,
        "norm_g": 1.0 + 0.1 * nrm(ks[6], (DEPTH, d), F32),
        "w_in": nrm(ks[7], (DEPTH, d, PROJ_WIDTH), F32) * d ** -0.5,
        "b_in": nrm(ks[8], (DEPTH, PROJ_WIDTH), F32) * 0.02,
        "diff_lam": nrm(ks[9], (DEPTH, 4, DA_QK), F32) * 0.1,
        "diff_g": 1.0 + 0.1 * nrm(ks[10], (DEPTH, DA_VDIM), F32),
        "hg_lb": nrm(ks[11], (DEPTH, HG_HEADS * HG_DK), F32),
        "hg_g": 1.0 + 0.1 * nrm(ks[12], (DEPTH, HG_DV), F32),
        "sw_sink": nrm(ks[13], (DEPTH, SW_HEADS), F32),
        "ml_g": 1.0 + 0.1 * nrm(ks[14], (DEPTH, ML_HD), F32),
        "w_out": nrm(ks[15], (DEPTH, MIX_WIDTH, d), F32) * MIX_WIDTH ** -0.5,
        "final_g": 1.0 + 0.1 * nrm(ks[16], (d,), F32),
    }


def reference(x, c, ctx, c_ctx, w_mod, b_mod, norm_g, w_in, b_in, diff_lam, diff_g,
              hg_lb, hg_g, sw_sink, ml_g, w_out, final_g):
    n_tok = x.shape[1]
    tabs_a = axial_rope_tables(n_tok, DA_QK)
    tabs_c = axial_rope_tables(n_tok, SW_HD)
    lb_all = jnp.cumsum(jax.nn.softmax(hg_lb.astype(F32), axis=0), axis=0)
    lb_all = lb_all - lb_all[0]
    for l in range(DEPTH):
        x, ctx = hybrid_layer(x, ctx, c, c_ctx, w_mod[l], b_mod[l], norm_g[l], w_in[l], b_in[l],
                              diff_lam[l], diff_g[l], lb_all[l], hg_g[l], sw_sink[l], ml_g[l],
                              w_out[l], l, tabs_a, tabs_c, l < DEPTH - 1)
    return rmsnorm(x, final_g)
```

```cpp
#include <hip/hip_runtime.h>
#include <hip/hip_cooperative_groups.h>
#include <cstdio>
namespace cg = cooperative_groups;

typedef unsigned short bf16_t;
#define DI __device__ __forceinline__

#ifndef N_LAUNCH_MODE
#define N_LAUNCH_MODE 1
#endif

constexpr int DM = 1024, NB = 8, NLAT = 2048, NCTX = 256, NTOK = 2304, ROWS = NB * NTOK;
constexpr int PW = 4368, PWP = 4480;
constexpr int A_Q = 0, A_K = 256, A_V = 512, B_Q = 768, B_FF = 1024, B_FB = 1280, B_I = 1536;
constexpr int C_Q = 1792, C_K = 2048, C_V = 2176, D_Q = 2304, D_K = 2560, D_V = 2816, D_G = 3072, D_OG = 3088, GATE = 3344;
constexpr float EPS = 1e-6f;

constexpr size_t WS_WINT = 0;
constexpr size_t WS_WOUTT = WS_WINT + (size_t)2 * PWP * DM * 2;
constexpr size_t WS_MOD = WS_WOUTT + (size_t)2 * DM * DM * 2;
constexpr size_t WS_ROPE = WS_MOD + (size_t)2 * 9 * 3072 * 4;
constexpr size_t WS_XRC = WS_ROPE + 65536;
constexpr size_t WS_HM = WS_XRC + (size_t)NB * NCTX * DM * 4;
constexpr size_t WS_P = WS_HM + (size_t)ROWS * DM * 2;
constexpr size_t WS_GATES = WS_P + (size_t)ROWS * PW * 2;
constexpr size_t SUMM_STRIDE = 64 * 64 * 4 + 256 + 256;
constexpr size_t WS_SUMM = WS_GATES + (size_t)ROWS * 16 * 4;
constexpr size_t WS_VTA = WS_SUMM + (size_t)2 * NB * 4 * 2 * 9 * SUMM_STRIDE;
constexpr size_t WS_VTC = WS_VTA + (size_t)NB * 4 * 64 * NTOK * 2;
constexpr size_t WS_CTL = WS_VTC + (size_t)NB * 2 * 64 * NTOK * 2;
constexpr size_t WS_END = WS_CTL + 16384;

struct Params {
  const float *x, *c, *ctx, *c_ctx, *w_mod, *b_mod, *norm_g, *w_in, *b_in, *diff_lam, *diff_g, *hg_lb, *hg_g, *sw_sink, *ml_g, *w_out, *final_g;
  float* out;
  unsigned char* ws;
  int ph_lo, ph_hi;
  int wave, pad;
};

DI int ltid_w(int wave) { int t; asm volatile("v_mbcnt_lo_u32_b32 %0, -1, 0\n\tv_mbcnt_hi_u32_b32 %0, -1, %0" : "=v"(t)); return (wave << 6) | t; }
DI size_t kblk(int row, int col, int nrows) { return ((size_t)(col >> 5) * nrows + row) * 32 + (col & 31); }
DI float bf2f(bf16_t v) { return __uint_as_float(((unsigned)v) << 16); }
typedef __bf16 hwbf16x2 __attribute__((ext_vector_type(2)));
typedef float hwf32x2 __attribute__((ext_vector_type(2)));
DI unsigned pk2(float a, float b) { hwf32x2 f = {a, b}; hwbf16x2 r = __builtin_convertvector(f, hwbf16x2); return __builtin_bit_cast(unsigned, r); }
DI bf16_t f2bf(float f) { return (bf16_t)(pk2(f, 0.f) & 0xffffu); }
DI float sigmoidf_(float z) { return 1.f / (1.f + __expf(-z)); }
DI float siluf_(float z) { return z / (1.f + __expf(-z)); }
DI float wave_sum(float v) {
#pragma unroll
  for (int o = 32; o >= 1; o >>= 1) v += __shfl_xor(v, o);
  return v;
}

constexpr int SMEM_BYTES = 72 * 1024;

DI void wt_tile(const Params& p, int l, int idx, unsigned char* smem, int tid) {
  float* tile = (float*)smem;
  const bool isin = idx < 16 * 70;
  int r = isin ? idx : idx - 16 * 70;
  const int NT = isin ? 70 : 16;
  const int kt = r / NT, nt = r % NT;
  const int Nsrc = isin ? PW : DM;
  const float* src = isin ? p.w_in + (size_t)l * DM * PW : p.w_out + (size_t)l * DM * DM;
  bf16_t* dst = isin ? (bf16_t*)(p.ws + WS_WINT) + (size_t)l * PWP * DM : (bf16_t*)(p.ws + WS_WOUTT) + (size_t)l * DM * DM;
  __syncthreads();
#pragma unroll
  for (int m = 0; m < 4; ++m) {
    const int e = tid + 256 * m;
    const int i = e >> 4, j4 = e & 15;
    const int n = nt * 64 + j4 * 4;
    float4 v = make_float4(0.f, 0.f, 0.f, 0.f);
    if (n < Nsrc) v = *(const float4*)(src + (size_t)(kt * 64 + i) * Nsrc + n);
    tile[i * 65 + j4 * 4 + 0] = v.x; tile[i * 65 + j4 * 4 + 1] = v.y; tile[i * 65 + j4 * 4 + 2] = v.z; tile[i * 65 + j4 * 4 + 3] = v.w;
  }
  __syncthreads();
#pragma unroll
  for (int m = 0; m < 2; ++m) {
    const int e = tid + 256 * m;
    const int j = e >> 3, i8 = e & 7;
    float x[8];
#pragma unroll
    for (int kk = 0; kk < 8; ++kk) x[kk] = tile[(i8 * 8 + kk) * 65 + j];
    *(uint4*)(dst + kblk(nt * 64 + j, kt * 64 + i8 * 8, isin ? PWP : DM)) = make_uint4(pk2(x[0], x[1]), pk2(x[2], x[3]), pk2(x[4], x[5]), pk2(x[6], x[7]));
  }
}
constexpr int WT_TILES = 16 * 70 + 16 * 16;

DI void ph_prep(const Params& p, unsigned char* smem, int bid, int nb) {
  const int tid = ltid_w(p.wave);
  float* MOD = (float*)(p.ws + WS_MOD);
  float2* T32 = (float2*)(p.ws + WS_ROPE);
  float2* T64 = T32 + 64 * 8;
  const int n_mod_items = 2 * 96;
  const int total = n_mod_items + WT_TILES + 1;
  for (int it = bid; it < total; it += nb) {
    if (it >= n_mod_items && it < n_mod_items + WT_TILES) {
      wt_tile(p, 0, it - n_mod_items, smem, tid);
    } else if (it < n_mod_items) {
      const int l = it / 96, jc = it % 96;
      float* sc = (float*)smem;
      __syncthreads();
      for (int e = tid; e < 9 * 1024; e += 256) {
        const int rr = e >> 10, k = e & 1023;
        const float v = rr < 8 ? p.c[rr * 1024 + k] : p.c_ctx[k];
        sc[e] = siluf_(v);
      }
      __syncthreads();
      const int jj = tid & 31, kq = tid >> 5;
      const int j = jc * 32 + jj;
      float acc[9];
#pragma unroll
      for (int rr = 0; rr < 9; ++rr) acc[rr] = 0.f;
      const float* wm = p.w_mod + (size_t)l * DM * 3072 + j;
#pragma unroll 1
      for (int k0 = kq * 128; k0 < kq * 128 + 128; k0 += 16) {
        float w[16];
#pragma unroll
        for (int u = 0; u < 16; ++u) w[u] = wm[(size_t)(k0 + u) * 3072];
#pragma unroll
        for (int u = 0; u < 16; ++u)
#pragma unroll
          for (int rr = 0; rr < 9; ++rr) acc[rr] += sc[rr * 1024 + k0 + u] * w[u];
      }
      __syncthreads();
      float* red = (float*)smem;
#pragma unroll
      for (int rr = 0; rr < 9; ++rr) red[(kq * 9 + rr) * 32 + jj] = acc[rr];
      __syncthreads();
      for (int e = tid; e < 9 * 32; e += 256) {
        const int rr = e >> 5, j2 = e & 31;
        float s = 0.f;
#pragma unroll
        for (int q8 = 0; q8 < 8; ++q8) s += red[(q8 * 9 + rr) * 32 + j2];
        MOD[((size_t)l * 9 + rr) * 3072 + jc * 32 + j2] = s + p.b_mod[l * 3072 + jc * 32 + j2];
      }
    } else {
      for (int e = tid; e < 64 * 8; e += 256) {
        const int pos = e >> 3, i = e & 7;
        const float inv = (float)pow(10000.0, -(double)(2 * i) / 16.0);
        const double a = (double)((float)pos * inv);
        T32[e] = make_float2((float)cos(a), (float)sin(a));
      }
      for (int e = tid; e < 64 * 16; e += 256) {
        const int pos = e >> 4, i = e & 15;
        const float inv = (float)pow(10000.0, -(double)(2 * i) / 32.0);
        const double a = (double)((float)pos * inv);
        T64[e] = make_float2((float)cos(a), (float)sin(a));
      }
    }
  }
}

DI const float* xsrc_row(const Params& p, int l, int b, int t) {
  if (t < NCTX) return (l == 0 ? p.ctx : (const float*)(p.ws + WS_XRC)) + ((size_t)b * NCTX + t) * DM;
  return (l == 0 ? p.x : (const float*)p.out) + ((size_t)b * NLAT + (t - NCTX)) * DM;
}

DI void ph_norm(const Params& p, int l, int bid, int nb) {
  const int tid_ = ltid_w(p.wave); const int lane = tid_ & 63, w = tid_ >> 6;
  bf16_t* H = (bf16_t*)(p.ws + WS_HM);
  const float* MOD = (const float*)(p.ws + WS_MOD);
  const float* g = p.norm_g + l * DM;
  for (int it = bid; it < ROWS / 8; it += nb) {
    float4 v[2][4];
    const float* mod[2];
#pragma unroll
    for (int rr = 0; rr < 2; ++rr) {
      const int row = it * 8 + rr * 4 + w;
      const int b = row / NTOK, t = row % NTOK;
      const float* src = xsrc_row(p, l, b, t);
      mod[rr] = MOD + ((size_t)l * 9 + (t < NCTX ? 8 : b)) * 3072;
#pragma unroll
      for (int i = 0; i < 4; ++i) v[rr][i] = *(const float4*)(src + (i * 64 + lane) * 4);
    }
#pragma unroll
    for (int rr = 0; rr < 2; ++rr) {
      const int row = it * 8 + rr * 4 + w;
      float ss = 0.f;
#pragma unroll
      for (int i = 0; i < 4; ++i) ss += v[rr][i].x * v[rr][i].x + v[rr][i].y * v[rr][i].y + v[rr][i].z * v[rr][i].z + v[rr][i].w * v[rr][i].w;
      ss = wave_sum(ss);
      const float rstd = rsqrtf(ss * (1.f / DM) + EPS);
#pragma unroll
      for (int i = 0; i < 4; ++i) {
        const int j = (i * 64 + lane) * 4;
        const float4 gg = *(const float4*)(g + j);
        const float4 sh = *(const float4*)(mod[rr] + j);
        const float4 sc = *(const float4*)(mod[rr] + 1024 + j);
        uint2 o;
        o.x = pk2(v[rr][i].x * rstd * gg.x * (1.f + sc.x) + sh.x, v[rr][i].y * rstd * gg.y * (1.f + sc.y) + sh.y);
        o.y = pk2(v[rr][i].z * rstd * gg.z * (1.f + sc.z) + sh.z, v[rr][i].w * rstd * gg.w * (1.f + sc.w) + sh.w);
        *(uint2*)(H + kblk(row, j, ROWS)) = o;
      }
    }
  }
}

template <class Epi>
DI void gemm_simple(const bf16_t* __restrict__ A, const bf16_t* __restrict__ Bt, int M, int NT64, int K, unsigned char* smem, int bid, int nb, Epi epi) {
  float* sA = (float*)smem;
  float* sB = sA + 16 * 68;
  const int tid = threadIdx.x, tx = tid & 15, ty = tid >> 4;
  const int MT = M / 64;
  for (int it = bid; it < MT * NT64; it += nb) {
    const int mt = it / NT64, nt = it % NT64;
    float acc[4][4];
#pragma unroll
    for (int i = 0; i < 4; ++i)
#pragma unroll
      for (int j = 0; j < 4; ++j) acc[i][j] = 0.f;
    const int lr = tid >> 2, lk = (tid & 3) * 4;
    const bf16_t* ap = A + (size_t)(mt * 64 + lr) * K + lk;
    const bf16_t* bp = Bt + (size_t)(nt * 64 + lr) * K + lk;
    for (int k0 = 0; k0 < K; k0 += 16) {
      const ushort4 av = *(const ushort4*)(ap + k0);
      const ushort4 bv = *(const ushort4*)(bp + k0);
      __syncthreads();
      sA[(lk + 0) * 68 + lr] = bf2f(av.x); sA[(lk + 1) * 68 + lr] = bf2f(av.y); sA[(lk + 2) * 68 + lr] = bf2f(av.z); sA[(lk + 3) * 68 + lr] = bf2f(av.w);
      sB[(lk + 0) * 68 + lr] = bf2f(bv.x); sB[(lk + 1) * 68 + lr] = bf2f(bv.y); sB[(lk + 2) * 68 + lr] = bf2f(bv.z); sB[(lk + 3) * 68 + lr] = bf2f(bv.w);
      __syncthreads();
#pragma unroll
      for (int kk = 0; kk < 16; ++kk) {
        const float4 a4 = *(const float4*)(sA + kk * 68 + ty * 4);
        const float4 b4 = *(const float4*)(sB + kk * 68 + tx * 4);
        const float a_[4] = {a4.x, a4.y, a4.z, a4.w}, b_[4] = {b4.x, b4.y, b4.z, b4.w};
#pragma unroll
        for (int i = 0; i < 4; ++i)
#pragma unroll
          for (int j = 0; j < 4; ++j) acc[i][j] += a_[i] * b_[j];
      }
    }
#pragma unroll
    for (int i = 0; i < 4; ++i)
#pragma unroll
      for (int j = 0; j < 4; ++j) epi(mt * 64 + ty * 4 + i, nt * 64 + tx * 4 + j, acc[i][j]);
  }
}

struct EpiIn {
  bf16_t* P; float* G; const float* bias;
  DI void operator()(int row, int col, float v) const {
    if (col >= PW) return;
    v += bias[col];
    P[(size_t)row * PW + col] = f2bf(v);
    if (col >= D_G && col < D_G + 16) G[(size_t)row * 16 + (col - D_G)] = v;
  }
};
struct EpiOut {
  const Params* p; int l; const float* MOD;
  DI void operator()(int row, int col, float v) const {
    const int b = row / NTOK, t = row % NTOK;
    if (t < NCTX && l == 1) return;
    const float g = MOD[((size_t)l * 9 + (t < NCTX ? 8 : b)) * 3072 + 2048 + col];
    const float xo = xsrc_row(*p, l, b, t)[col];
    float* dst = (t < NCTX) ? (float*)(p->ws + WS_XRC) + ((size_t)b * NCTX + t) * DM : p->out + ((size_t)b * NLAT + (t - NCTX)) * DM;
    dst[col] = xo + g * v;
  }
};


using bf16x8 = __attribute__((ext_vector_type(8))) short;
using f32x16 = __attribute__((ext_vector_type(16))) float;
using f32x2 = __attribute__((ext_vector_type(2))) float;
#define MFMA32(a, b, c) __builtin_amdgcn_mfma_f32_32x32x16_bf16((a), (b), (c), 0, 0, 0)
DI int crow(int reg, int h) { return (reg & 3) + 8 * (reg >> 2) + 4 * h; }

#define RAW_BARRIER() do { asm volatile("s_waitcnt lgkmcnt(0)" ::: "memory"); __builtin_amdgcn_s_barrier(); } while (0)
template <int WM, class Epi>
DI void gemm_mfma(const bf16_t* __restrict__ A, const bf16_t* __restrict__ Bt, int Arows, int Brows, int MT, int NT, unsigned char* smem, int bid, int nb, int wave, Epi epi) {
  constexpr int K = DM;
  constexpr int BMROWS = WM * 64;
  constexpr int A_BYTES = BMROWS * 64;
  constexpr int STAGE = A_BYTES + 128 * 64;
  constexpr int NA = BMROWS / 16;
  constexpr int NI = (NA + 8) / 4;
  const int tid = ltid_w(wave), lane = tid & 63, wv = tid >> 6;
  const int wm = wv >> 1, wn = wv & 1;
  const int r = lane & 31, h = lane >> 5;
  const int lrow = lane >> 2, lpc = lane & 3;
  const unsigned lds0 = (unsigned)(size_t)smem;
  const int rowA = wm * (WM * 32) + r, rowB = wn * 64 + r;
  const unsigned offA0 = (unsigned)(rowA * 64 + (((0 + h) ^ ((rowA >> 2) & 3)) << 4)), offA1 = (unsigned)(rowA * 64 + (((2 + h) ^ ((rowA >> 2) & 3)) << 4));
  const unsigned offB0 = (unsigned)(A_BYTES + rowB * 64 + (((0 + h) ^ ((rowB >> 2) & 3)) << 4)), offB1 = (unsigned)(A_BYTES + rowB * 64 + (((2 + h) ^ ((rowB >> 2) & 3)) << 4));
  const int PN = (NT % 7 == 0) ? 35 : 8, PM = (NT % 7 == 0) ? 2 : 8, NPN = NT / PN;
  const bool xsplit = (nb % 8 == 0) && ((MT * NT) % 8 == 0);
  const int per = xsplit ? (MT * NT) / 8 : MT * NT, xq = xsplit ? bid % 8 : 0, lstep = xsplit ? nb / 8 : nb, l0 = xsplit ? bid / 8 : bid;
  for (int li = l0; li < per; li += lstep) {
    const int wi = xq * per + li;
    const int patch = wi / (PM * PN), within = wi % (PM * PN);
    const int mt = epi.mt_of((patch / NPN) * PM + within / PN), nt = ((patch % NPN) * PN + within % PN + xq * 4) % NT;
    f32x16 acc[WM][2];
#pragma unroll
    for (int a = 0; a < WM; ++a)
#pragma unroll
      for (int b = 0; b < 2; ++b)
#pragma unroll
        for (int i = 0; i < 16; ++i) acc[a][b][i] = 0.f;
    constexpr int NAW = NA / 4;
    const int wvu = __builtin_amdgcn_readfirstlane(wv);
    const unsigned voff = (unsigned)((lrow * 32 + ((lpc ^ ((lrow >> 2) & 3)) << 3)) * 2);
    const char* abase = (const char*)(A + (size_t)(mt * BMROWS + wvu * NAW * 16) * 32);
    const char* bbase = (const char*)(Bt + (size_t)(nt * 128 + wvu * 2 * 16) * 32);
    const size_t astep = (size_t)Arows * 64, bstep = (size_t)Brows * 64;
    auto issue = [&](int kt, int buf) {
#pragma unroll
      for (int i = 0; i < NAW; ++i)
        __builtin_amdgcn_global_load_lds((const unsigned*)(abase + kt * astep + i * 1024 + voff),
                                         (__attribute__((address_space(3))) unsigned*)(smem + buf * STAGE + (wvu * NAW + i) * 1024), 16, 0, 0);
#pragma unroll
      for (int i = 0; i < 2; ++i)
        __builtin_amdgcn_global_load_lds((const unsigned*)(bbase + kt * bstep + i * 1024 + voff),
                                         (__attribute__((address_space(3))) unsigned*)(smem + buf * STAGE + A_BYTES + (wvu * 2 + i) * 1024), 16, 0, 0);
    };
    RAW_BARRIER();
    constexpr int NST = (WM == 2) ? 4 : 3;
    constexpr int NKT = K / 32;
#pragma unroll
    for (int s = 0; s < NST - 1; ++s) issue(s, s);
    bf16x8 fa0[WM], fb0[2], fa1[WM], fb1[2];
#pragma unroll
    for (int mi = 0; mi < WM; ++mi) { fa0[mi] = bf16x8{0, 0, 0, 0, 0, 0, 0, 0}; fa1[mi] = fa0[mi]; }
    fb0[0] = bf16x8{0, 0, 0, 0, 0, 0, 0, 0}; fb0[1] = fb0[0]; fb1[0] = fb0[0]; fb1[1] = fb0[0];
#define GEMM_READ4(A_, B_, FA, FB) asm volatile( \
        "ds_read_b128 %0, %6\n\tds_read_b128 %1, %6 offset:2048\n\tds_read_b128 %2, %6 offset:4096\n\tds_read_b128 %3, %6 offset:6144\n\t" \
        "ds_read_b128 %4, %7\n\tds_read_b128 %5, %7 offset:2048" \
        : "=&v"(FA[0]), "=&v"(FA[1]), "=&v"(FA[2]), "=&v"(FA[3]), "=&v"(FB[0]), "=&v"(FB[1]) : "v"(A_), "v"(B_) : "memory")
#define GEMM_READ2(A_, B_, FA, FB) asm volatile( \
        "ds_read_b128 %0, %4\n\tds_read_b128 %1, %4 offset:2048\n\tds_read_b128 %2, %5\n\tds_read_b128 %3, %5 offset:2048" \
        : "=&v"(FA[0]), "=&v"(FA[1]), "=&v"(FB[0]), "=&v"(FB[1]) : "v"(A_), "v"(B_) : "memory")
#define GEMM_WAIT4(FA, FB) asm volatile("s_waitcnt lgkmcnt(0)" : "+v"(FA[0]), "+v"(FA[1]), "+v"(FA[2]), "+v"(FA[3]), "+v"(FB[0]), "+v"(FB[1]) :: "memory")
#define GEMM_WAIT2(FA, FB) asm volatile("s_waitcnt lgkmcnt(0)" : "+v"(FA[0]), "+v"(FA[1]), "+v"(FB[0]), "+v"(FB[1]) :: "memory")
#define GEMM_MMA(FA, FB) do { __builtin_amdgcn_s_setprio(1); \
      _Pragma("unroll") for (int mi = 0; mi < WM; ++mi) _Pragma("unroll") for (int ni = 0; ni < 2; ++ni) acc[mi][ni] = MFMA32(FA[mi], FB[ni], acc[mi][ni]); \
      __builtin_amdgcn_s_setprio(0); } while (0)
#pragma unroll 1
    for (int kt = 0; kt < NKT; ++kt) {
      const int ahead = (NKT - 1 - kt < NST - 2) ? (NKT - 1 - kt) : (NST - 2);
      if (NI == 4) { if (ahead == 2) asm volatile("s_waitcnt vmcnt(8)" ::: "memory"); else if (ahead == 1) asm volatile("s_waitcnt vmcnt(4)" ::: "memory"); else asm volatile("s_waitcnt vmcnt(0)" ::: "memory"); }
      else { if (ahead == 1) asm volatile("s_waitcnt vmcnt(6)" ::: "memory"); else asm volatile("s_waitcnt vmcnt(0)" ::: "memory"); }
      RAW_BARRIER();
      if (kt + NST - 1 < NKT) issue(kt + NST - 1, (kt + NST - 1) % NST);
      const unsigned sb = lds0 + (unsigned)((kt % NST) * STAGE);
      const unsigned a0 = sb + offA0, a1 = sb + offA1, b0 = sb + offB0, b1 = sb + offB1;
      if constexpr (WM == 4) GEMM_READ4(a0, b0, fa0, fb0); else GEMM_READ2(a0, b0, fa0, fb0);
      GEMM_MMA(fa1, fb1);
      if constexpr (WM == 4) { GEMM_WAIT4(fa0, fb0); GEMM_READ4(a1, b1, fa1, fb1); } else { GEMM_WAIT2(fa0, fb0); GEMM_READ2(a1, b1, fa1, fb1); }
      GEMM_MMA(fa0, fb0);
    }
    if constexpr (WM == 4) GEMM_WAIT4(fa1, fb1); else GEMM_WAIT2(fa1, fb1);
    GEMM_MMA(fa1, fb1);
    int r2 = r, h2 = h;
    asm volatile("" : "+v"(r2), "+v"(h2));
    epi(mt, nt, wm, wn, r2, h2, acc);
  }
}

template <int WM>
struct EpiInM {
  bf16_t* P; float* G; const float* bias; const float2* T32; const float2* T64; bf16_t* VTA; bf16_t* VTC; unsigned char* smem;
  DI int mt_of(int mtv) const { return mtv; }
  DI void operator()(int mt, int nt, int wm, int wn, int r, int h, f32x16 (&acc)[WM][2]) const {
    constexpr int LD = 132;
    float* T = (float*)smem;
    const int tid = wm * 128 + wn * 64 + h * 32 + r;
#pragma unroll
    for (int ps = 0; ps < WM / 2; ++ps) {
      RAW_BARRIER();
#pragma unroll
      for (int mh = 0; mh < 2; ++mh)
#pragma unroll
        for (int ni = 0; ni < 2; ++ni)
#pragma unroll
          for (int i = 0; i < 16; ++i)
            T[(wm * 64 + mh * 32 + (i & 3) + 8 * (i >> 2) + 4 * h) * LD + wn * 64 + ni * 32 + r] = acc[ps * 2 + mh][ni][i];
      RAW_BARRIER();
      const int ropemode0 = (nt < 4) ? 1 : ((nt >= 14 && nt <= 16) ? 2 : 0);
#pragma unroll
      for (int j = 0; j < 8; ++j) {
        const int id = tid + 256 * j;
        const int lr = id >> 4, cc = id & 15;
        const int row = mt * (WM * 64) + (lr >> 6) * (WM * 32) + ps * 64 + (lr & 63);
        const int col0 = nt * 128 + cc * 8;
        if (col0 < PW) {
          const int t = row % NTOK;
          const int ropemode = (t >= NCTX) ? ropemode0 : 0;
          const float4 a0 = *(const float4*)(T + lr * LD + cc * 8), a1 = *(const float4*)(T + lr * LD + cc * 8 + 4);
          const float4 b0 = *(const float4*)(bias + col0), b1 = *(const float4*)(bias + col0 + 4);
          float v[8] = {a0.x + b0.x, a0.y + b0.y, a0.z + b0.z, a0.w + b0.w, a1.x + b1.x, a1.y + b1.y, a1.z + b1.z, a1.w + b1.w};
          if (ropemode != 0) {
            const int pc = (ropemode == 1) ? (cc ^ 1) : (cc ^ 2);
            const float4 p0 = *(const float4*)(T + lr * LD + pc * 8), p1 = *(const float4*)(T + lr * LD + pc * 8 + 4);
            const float4 c0 = *(const float4*)(bias + nt * 128 + pc * 8), c1 = *(const float4*)(bias + nt * 128 + pc * 8 + 4);
            const float pr[8] = {p0.x + c0.x, p0.y + c0.y, p0.z + c0.z, p0.w + c0.w, p1.x + c1.x, p1.y + c1.y, p1.z + c1.z, p1.w + c1.w};
            const int tok = t - NCTX;
            const int q = (ropemode == 1) ? (cc & 3) : ((cc & 7) >> 1);
            const int pos = (q < 2) ? (tok >> 6) : (tok & 63);
            const float2* tab = (ropemode == 1) ? (T32 + pos * 8) : (T64 + pos * 16 + (cc & 1) * 8);
            const float sgn = (q & 1) ? 1.f : -1.f;
#pragma unroll
            for (int k = 0; k < 8; ++k) { const float2 cs = tab[k]; v[k] = v[k] * cs.x + sgn * pr[k] * cs.y; }
          }
          *(uint4*)(P + (size_t)row * PW + col0) = make_uint4(pk2(v[0], v[1]), pk2(v[2], v[3]), pk2(v[4], v[5]), pk2(v[6], v[7]));
          if (nt == 24 && cc < 2) {
            *(float4*)(G + (size_t)row * 16 + cc * 8) = make_float4(v[0], v[1], v[2], v[3]);
            *(float4*)(G + (size_t)row * 16 + cc * 8 + 4) = make_float4(v[4], v[5], v[6], v[7]);
          }
        }
      }
      if (nt == 4 || nt == 5 || nt == 17) {
#pragma unroll
        for (int j = 0; j < 8; ++j) {
          const int id = tid + 256 * j;
          const int c = id & 127, rg = id >> 7;
          const int lr0 = rg * 8;
          const int row = mt * (WM * 64) + (lr0 >> 6) * (WM * 32) + ps * 64 + (lr0 & 63);
          const int b = row / NTOK, t = row % NTOK;
          const int col = nt * 128 + c;
          const float bb = bias[col];
          float x[8];
#pragma unroll
          for (int k = 0; k < 8; ++k) x[k] = T[(lr0 + k) * LD + c] + bb;
          bf16_t* vt = (nt == 17) ? VTC + ((size_t)b * 128 + (col - C_V)) * NTOK : VTA + ((size_t)b * 256 + (col - A_V)) * NTOK;
          *(uint4*)(vt + t) = make_uint4(pk2(x[0], x[1]), pk2(x[2], x[3]), pk2(x[4], x[5]), pk2(x[6], x[7]));
        }
      }
    }
  }
};
template <int WM>
struct EpiNull {
  float* sink;
  DI int mt_of(int mtv) const { return mtv; }
  DI void operator()(int mt, int nt, int wm, int wn, int r, int h, f32x16 (&acc)[WM][2]) const {
    float s = 0.f;
#pragma unroll
    for (int a = 0; a < WM; ++a)
#pragma unroll
      for (int b = 0; b < 2; ++b)
#pragma unroll
        for (int i = 0; i < 16; ++i) s += acc[a][b][i];
    if (s == 1.2345e30f) sink[0] = s;
  }
};
template <int WM>
struct EpiOutM {
  const Params* p; int l; const float* MOD; unsigned char* smem; int mode;
  DI int mt_of(int mtv) const { return mode == 1 ? (WM == 4 ? (mtv >> 3) * 9 + 1 + (mtv & 7) : (mtv >> 4) * 18 + 2 + (mtv & 15)) : (WM == 4 ? mtv * 9 : (mtv >> 1) * 18 + (mtv & 1)); }
  DI void operator()(int mt, int nt, int wm, int wn, int r, int h, f32x16 (&acc)[WM][2]) const {
    constexpr int LD = 132;
    float* T = (float*)smem;
    const int tid = wm * 128 + wn * 64 + h * 32 + r;
#pragma unroll
    for (int ps = 0; ps < WM / 2; ++ps) {
      RAW_BARRIER();
#pragma unroll
      for (int mh = 0; mh < 2; ++mh)
#pragma unroll
        for (int ni = 0; ni < 2; ++ni)
#pragma unroll
          for (int i = 0; i < 16; ++i)
            T[(wm * 64 + mh * 32 + (i & 3) + 8 * (i >> 2) + 4 * h) * LD + wn * 64 + ni * 32 + r] = acc[ps * 2 + mh][ni][i];
      RAW_BARRIER();
#pragma unroll 4
      for (int j = 0; j < 16; ++j) {
        const int id = tid + 256 * j;
        const int lr = id >> 5, cc = id & 31;
        const int row = mt * (WM * 64) + (lr >> 6) * (WM * 32) + ps * 64 + (lr & 63);
        const int b = row / NTOK, t = row % NTOK;
        const bool isctx = t < NCTX;
        if (isctx && l == 1) continue;
        const int col = nt * 128 + cc * 4;
        const float4 a = *(const float4*)(T + lr * LD + cc * 4);
        const float4 g = *(const float4*)(MOD + ((size_t)l * 9 + (isctx ? 8 : b)) * 3072 + 2048 + col);
        const float4 xo = *(const float4*)(xsrc_row(*p, l, b, t) + col);
        float* dst = (isctx ? (float*)(p->ws + WS_XRC) + ((size_t)b * NCTX + t) * DM : p->out + ((size_t)b * NLAT + (t - NCTX)) * DM) + col;
        *(float4*)dst = make_float4(xo.x + g.x * a.x, xo.y + g.y * a.y, xo.z + g.z * a.z, xo.w + g.w * a.w);
      }
    }
  }
};

DI void ph_rope(const Params& p, int bid, int nb) {
  bf16_t* P = (bf16_t*)(p.ws + WS_P);
  const float2* T32 = (const float2*)(p.ws + WS_ROPE);
  const float2* T64 = T32 + 64 * 8;
  const int total = NB * NLAT * 448;
  for (int e = bid * 256 + threadIdx.x; e < total; e += nb * 256) {
    const int tokg = e / 448, pr = e % 448;
    const int b = tokg / NLAT, tok = tokg % NLAT;
    bf16_t* rowp = P + ((size_t)b * NTOK + NCTX + tok) * PW;
    int c1, c2; float2 cs;
    if (pr < 256) {
      const int g = pr >> 4, pi = pr & 15;
      if (pi < 8) { c1 = g * 32 + pi; c2 = c1 + 8; cs = T32[(tok >> 6) * 8 + pi]; }
      else { const int i = pi - 8; c1 = g * 32 + 16 + i; c2 = c1 + 8; cs = T32[(tok & 63) * 8 + i]; }
    } else {
      const int q = pr - 256; const int g = q >> 5, pi = q & 31;
      if (pi < 16) { c1 = C_Q + g * 64 + pi; c2 = c1 + 16; cs = T64[(tok >> 6) * 16 + pi]; }
      else { const int i = pi - 16; c1 = C_Q + g * 64 + 32 + i; c2 = c1 + 16; cs = T64[(tok & 63) * 16 + i]; }
    }
    const float x1 = bf2f(rowp[c1]), x2 = bf2f(rowp[c2]);
    rowp[c1] = f2bf(x1 * cs.x - x2 * cs.y);
    rowp[c2] = f2bf(x2 * cs.x + x1 * cs.y);
  }
}

DI int seq_tok(int dir, int pos) { return dir == 0 ? pos : (pos < NCTX ? NCTX - 1 - pos : 2559 - pos); }

DI void hgrn_scan(const Params& p, int l, int b, int h, int dir, unsigned char* smem) {
  const int tid = ltid_w(p.wave), lane = tid & 63, w = tid >> 6;
  bf16_t* P = (bf16_t*)(p.ws + WS_P);
  float* sf = (float*)smem;
  float* sk = sf + 1024;
  float* sq = sk + 1024;
  float* si = sq + 1024;
  float* sp = si + 1024;
  const int fcol = (dir ? B_FB : B_FF) + h * 64;
  float S[16];
#pragma unroll
  for (int i = 0; i < 16; ++i) S[i] = 0.f;
  for (int c = 0; c < NTOK / 16; ++c) {
    __syncthreads();
    for (int e = tid; e < 1024; e += 256) {
      const int tt = e >> 6, k = e & 63;
      const int t = seq_tok(dir, c * 16 + tt);
      const bf16_t* rp = P + ((size_t)b * NTOK + t) * PW;
      float lb = 0.f;
      if (l == 1) lb = sigmoidf_(p.hg_lb[256 + h * 64 + k] - p.hg_lb[h * 64 + k]);
      const float z = bf2f(rp[fcol + k]);
      const float sg = sigmoidf_(z);
      sf[e] = lb + (1.f - lb) * sg;
      sk[e] = (1.f - lb) * (1.f - sg);
      sq[e] = bf2f(rp[B_Q + h * 64 + k]) * 0.125f;
      si[e] = bf2f(rp[B_I + h * 64 + k]);
    }
    __syncthreads();
    for (int tt = 0; tt < 16; ++tt) {
      const float iv = si[tt * 64 + lane];
      float o = 0.f;
#pragma unroll
      for (int kk = 0; kk < 16; ++kk) {
        const int k = w * 16 + kk;
        S[kk] = sf[tt * 64 + k] * S[kk] + sk[tt * 64 + k] * iv;
        o += sq[tt * 64 + k] * S[kk];
      }
      sp[(w * 16 + tt) * 64 + lane] = o;
    }
    __syncthreads();
    for (int e = tid; e < 1024; e += 256) {
      const int tt = e >> 6, v = e & 63;
      const int t = seq_tok(dir, c * 16 + tt);
      const float o = sp[(0 * 16 + tt) * 64 + v] + sp[(1 * 16 + tt) * 64 + v] + sp[(2 * 16 + tt) * 64 + v] + sp[(3 * 16 + tt) * 64 + v];
      P[((size_t)b * NTOK + t) * PW + fcol + v] = f2bf(o);
    }
  }
}

DI void attnA_naive(const Params& p, int l, int b, int h, int qb, unsigned char* smem) {
  const int tid = ltid_w(p.wave);
  const bf16_t* P = (const bf16_t*)(p.ws + WS_P);
  bf16_t* MIX = (bf16_t*)(p.ws + WS_HM);
  float* sk = (float*)smem;
  float* sv = sk + 2048;
  float* so = sv + 2048;
  const int mp = tid >> 7;
  const int t = qb * 128 + (tid & 127);
  const size_t row = (size_t)b * NTOK + t;
  const float lam_init = 0.8f - 0.6f * __expf(-0.3f * (float)l);
  float s01 = 0.f, s23 = 0.f;
  for (int i = 0; i < 32; ++i) {
    s01 += p.diff_lam[l * 128 + i] * p.diff_lam[l * 128 + 32 + i];
    s23 += p.diff_lam[l * 128 + 64 + i] * p.diff_lam[l * 128 + 96 + i];
  }
  const float lam = expf(s01) - expf(s23) + lam_init;
  const float scale = 0.17677669529663687f;
  float q[32], o0[64];
#pragma unroll
  for (int d = 0; d < 32; ++d) q[d] = bf2f(P[row * PW + A_Q + h * 64 + mp * 32 + d]) * scale;
#pragma unroll
  for (int d = 0; d < 64; ++d) o0[d] = 0.f;
  float m0 = -1e30f, l0 = 0.f;
  const int nkeys = (qb < 2) ? NCTX : NTOK;
  for (int k0 = 0; k0 < nkeys; k0 += 32) {
    __syncthreads();
    for (int e = tid; e < 2048; e += 256) {
      const int kk = e >> 6, d = e & 63;
      const bf16_t* rp = P + ((size_t)b * NTOK + k0 + kk) * PW;
      sk[e] = bf2f(rp[A_K + h * 64 + d]);
      sv[e] = bf2f(rp[A_V + h * 64 + d]);
    }
    __syncthreads();
    for (int kk = 0; kk < 32; ++kk) {
      float s0 = 0.f;
#pragma unroll
      for (int d = 0; d < 32; ++d) s0 += q[d] * sk[kk * 64 + mp * 32 + d];
      if (s0 > m0) { const float a = __expf(m0 - s0); l0 *= a;
#pragma unroll
        for (int d = 0; d < 64; ++d) o0[d] *= a;
        m0 = s0; }
      const float p0 = __expf(s0 - m0);
      l0 += p0;
#pragma unroll
      for (int d = 0; d < 64; ++d) o0[d] += p0 * sv[kk * 64 + d];
    }
  }
  const float i0 = (mp ? lam : 1.f) / l0;
  if (mp) {
#pragma unroll
    for (int d = 0; d < 64; ++d) so[(tid & 127) * 65 + d] = o0[d] * i0;
  }
  __syncthreads();
  if (!mp) {
    float ss = 0.f;
#pragma unroll
    for (int d = 0; d < 64; ++d) { o0[d] = o0[d] * i0 - so[tid * 65 + d]; ss += o0[d] * o0[d]; }
    const float rstd = rsqrtf(ss * (1.f / 64.f) + EPS) * (1.f - lam_init);
#pragma unroll
    for (int d = 0; d < 64; ++d) {
      const float gt = siluf_(bf2f(P[row * PW + GATE + h * 64 + d]));
      MIX[row * DM + h * 64 + d] = f2bf(o0[d] * rstd * p.diff_g[l * 64 + d] * gt);
    }
  }
}

DI void attnC_naive(const Params& p, int l, int b, int hq, int qb, unsigned char* smem) {
  const int tid = ltid_w(p.wave);
  const bf16_t* P = (const bf16_t*)(p.ws + WS_P);
  bf16_t* MIX = (bf16_t*)(p.ws + WS_HM);
  float* sk = (float*)smem;
  float* sv = sk + 2048;
  const int kvh = hq >> 1;
  const int t = qb * 256 + tid;
  const size_t row = (size_t)b * NTOK + t;
  float q[64], o[64];
#pragma unroll
  for (int d = 0; d < 64; ++d) { q[d] = bf2f(P[row * PW + C_Q + hq * 64 + d]) * 0.125f; o[d] = 0.f; }
  float m = p.sw_sink[l * 4 + hq], lsum = 1.f;
  const int i = t - NCTX;
  int jlo = 0, jhi = 0;
  if (qb > 0) { jlo = (qb - 1) * 256 - 128; if (jlo < 0) jlo = 0; jhi = (qb - 1) * 256 + 256 + 128; if (jhi > NLAT) jhi = NLAT; }
  const int ntiles = 8 + (jhi - jlo) / 32;
  for (int tl = 0; tl < ntiles; ++tl) {
    const int kt0 = tl < 8 ? tl * 32 : NCTX + jlo + (tl - 8) * 32;
    __syncthreads();
    for (int e = tid; e < 2048; e += 256) {
      const int kk = e >> 6, d = e & 63;
      const bf16_t* rp = P + ((size_t)b * NTOK + kt0 + kk) * PW;
      sk[e] = bf2f(rp[C_K + kvh * 64 + d]);
      sv[e] = bf2f(rp[C_V + kvh * 64 + d]);
    }
    __syncthreads();
    for (int kk = 0; kk < 32; ++kk) {
      if (tl >= 8) { const int j = kt0 + kk - NCTX; const int dd = i - j; if (dd > 128 || dd < -128) continue; }
      float s = 0.f;
#pragma unroll
      for (int d = 0; d < 64; ++d) s += q[d] * sk[kk * 64 + d];
      if (s > m) { const float a = __expf(m - s); lsum *= a;
#pragma unroll
        for (int d = 0; d < 64; ++d) o[d] *= a;
        m = s; }
      const float pp = __expf(s - m);
      lsum += pp;
#pragma unroll
      for (int d = 0; d < 64; ++d) o[d] += pp * sv[kk * 64 + d];
    }
  }
  const float inv = 1.f / lsum;
#pragma unroll
  for (int d = 0; d < 64; ++d) {
    const float gt = siluf_(bf2f(P[row * PW + GATE + 512 + hq * 64 + d]));
    MIX[row * DM + 512 + hq * 64 + d] = f2bf(o[d] * inv * gt);
  }
}


DI bf16x8 pack8(const f32x16& x, int s) {
  const uint4 u = make_uint4(pk2(x[8 * s + 0], x[8 * s + 1]), pk2(x[8 * s + 2], x[8 * s + 3]), pk2(x[8 * s + 4], x[8 * s + 5]), pk2(x[8 * s + 6], x[8 * s + 7]));
  return __builtin_bit_cast(bf16x8, u);
}
template <int MODE>
DI void attn_mfma(const Params& p, int l, int b, int hd, int qb, unsigned char* smem) {
  constexpr int KS = MODE ? 4 : 2;
  constexpr int QPB = MODE ? 128 : 64;
  const int tid = ltid_w(p.wave), lane = tid & 63, wv = tid >> 6, r = lane & 31, h2 = lane >> 5;
  const int mp = MODE ? 0 : (wv >> 1);
  const bf16_t* P = (const bf16_t*)(p.ws + WS_P);
  bf16_t* MIX = (bf16_t*)(p.ws + WS_HM);
  const int kvh = MODE ? (hd >> 1) : hd;
  const bf16_t* VT = MODE ? (const bf16_t*)(p.ws + WS_VTC) + ((size_t)(b * 2 + kvh) * 64) * NTOK : (const bf16_t*)(p.ws + WS_VTA) + ((size_t)(b * 4 + hd) * 64) * NTOK;
  const int qcol = MODE ? C_Q + hd * 64 : A_Q + hd * 64;
  const int kcol = MODE ? C_K + kvh * 64 : A_K + hd * 64;
  unsigned char* sK = smem;
  unsigned char* sV = smem + 8192;
  const int tq = qb * QPB + (MODE ? wv : (wv & 1)) * 32 + r;
  const size_t qrow = (size_t)b * NTOK + tq;
  bf16x8 qf[KS];
#pragma unroll
  for (int ks = 0; ks < KS; ++ks) qf[ks] = *(const bf16x8*)(P + qrow * PW + qcol + (2 * (mp * 2 + ks) + h2) * 8);
  const bool isctx = qb * QPB < NCTX;
  int ntiles, band_lo = 0;
  if (MODE == 0) ntiles = isctx ? 4 : 36;
  else {
    if (isctx) ntiles = 4;
    else { const int i0 = qb * QPB - NCTX; int lo = i0 - 128; if (lo < 0) lo = 0; int hi = i0 + 256; if (hi > NLAT) hi = NLAT; band_lo = lo; ntiles = 4 + (hi - lo) / 64; }
  }
  const float cexp = (MODE ? 0.125f : 0.17677669529663687f) * 1.4426950408889634f;
  float mrun = MODE ? p.sw_sink[l * 4 + hd] * 1.4426950408889634f : -1e30f;
  float lsum = (MODE && h2 == 0) ? 1.f : 0.f;
  f32x16 O[2];
#pragma unroll
  for (int vt = 0; vt < 2; ++vt)
#pragma unroll
    for (int i = 0; i < 16; ++i) O[vt][i] = 0.f;
  const int lrow = tid >> 3, lc = tid & 7;
  auto tile_base = [&](int j) -> int { return (MODE == 0 || j < 4) ? j * 64 : NCTX + band_lo + (j - 4) * 64; };
  uint4 gk00, gk01, gk10, gk11, gv00, gv01, gv10, gv11;
#define ATT_LOAD(tb_, k0_, k1_, v0_, v1_) do { const int tb__ = (tb_); \
    k0_ = *(const uint4*)(P + ((size_t)b * NTOK + tb__ + lrow) * PW + kcol + lc * 8); \
    k1_ = *(const uint4*)(P + ((size_t)b * NTOK + tb__ + lrow + 32) * PW + kcol + lc * 8); \
    v0_ = *(const uint4*)(VT + (size_t)lrow * NTOK + tb__ + lc * 8); \
    v1_ = *(const uint4*)(VT + (size_t)(lrow + 32) * NTOK + tb__ + lc * 8); } while (0)
#define ATT_STORE(hf_, k0_, k1_, v0_, v1_) do { unsigned char* sKh = sK + (hf_) * 16896; unsigned char* sVh = sV + (hf_) * 16896; \
    const int off = lrow * 128 + ((lc ^ ((lrow >> 1) & 7)) << 4); \
    *(uint4*)(sKh + off) = k0_; *(uint4*)(sKh + off + 4096) = k1_; \
    *(uint2*)(sVh + lrow * 136 + lc * 16) = make_uint2(v0_.x, v0_.y); *(uint2*)(sVh + lrow * 136 + lc * 16 + 8) = make_uint2(v0_.z, v0_.w); \
    *(uint2*)(sVh + (lrow + 32) * 136 + lc * 16) = make_uint2(v1_.x, v1_.y); *(uint2*)(sVh + (lrow + 32) * 136 + lc * 16 + 8) = make_uint2(v1_.z, v1_.w); } while (0)
  ATT_LOAD(tile_base(0), gk00, gk01, gv00, gv01);
  ATT_LOAD(tile_base(1), gk10, gk11, gv10, gv11);
  for (int j = 0; j < ntiles; j += 2) {
    __syncthreads();
    ATT_STORE(0, gk00, gk01, gv00, gv01);
    ATT_STORE(1, gk10, gk11, gv10, gv11);
    __syncthreads();
    if (j + 2 < ntiles) {
      ATT_LOAD(tile_base(j + 2), gk00, gk01, gv00, gv01);
      ATT_LOAD(tile_base(j + 3), gk10, gk11, gv10, gv11);
    }
    f32x16 SA0, SA1, SB0, SB1;
#pragma unroll
    for (int i = 0; i < 16; ++i) { SA0[i] = 0.f; SA1[i] = 0.f; SB0[i] = 0.f; SB1[i] = 0.f; }
#pragma unroll
    for (int ks = 0; ks < KS; ++ks) {
      const int kk = mp * 2 + ks;
      const int key0 = r, key1 = 32 + r;
      const int o0 = key0 * 128 + (((2 * kk + h2) ^ ((key0 >> 1) & 7)) << 4), o1 = key1 * 128 + (((2 * kk + h2) ^ ((key1 >> 1) & 7)) << 4);
      SA0 = MFMA32(*(const bf16x8*)(sK + o0), qf[ks], SA0);
      SA1 = MFMA32(*(const bf16x8*)(sK + o1), qf[ks], SA1);
      SB0 = MFMA32(*(const bf16x8*)(sK + 16896 + o0), qf[ks], SB0);
      SB1 = MFMA32(*(const bf16x8*)(sK + 16896 + o1), qf[ks], SB1);
    }
#pragma unroll
    for (int hf = 0; hf < 2; ++hf) {
    const unsigned char* sVc = sV + hf * 16896;
    const int tbcur = tile_base(j + hf);
    f32x16 S[2];
    S[0] = hf == 0 ? SA0 : SB0;
    S[1] = hf == 0 ? SA1 : SB1;
    if (MODE == 1 && j + hf >= 4) {
      const int iq = tq - NCTX;
      const int jb = tbcur - NCTX;
#pragma unroll
      for (int mt = 0; mt < 2; ++mt)
#pragma unroll
        for (int i = 0; i < 16; ++i) {
          const int dd = iq - (jb + mt * 32 + crow(i, h2));
          if (dd > 128 || dd < -128) S[mt][i] = -1e30f;
        }
    }
    float mx = -1e30f;
#pragma unroll
    for (int mt = 0; mt < 2; ++mt)
#pragma unroll
      for (int i = 0; i < 16; ++i) mx = fmaxf(mx, S[mt][i]);
    mx = fmaxf(mx, __shfl_xor(mx, 32));
    const float zmx = mx * cexp;
    if (__any(zmx > mrun + 8.f)) {
      const float mnew = fmaxf(mrun, zmx);
      const float alpha = __builtin_amdgcn_exp2f(mrun - mnew);
      mrun = mnew;
      lsum *= alpha;
      const f32x2 al2 = {alpha, alpha};
#pragma unroll
      for (int vt = 0; vt < 2; ++vt)
#pragma unroll
        for (int i = 0; i < 8; ++i) {
          f32x2 o = {O[vt][2 * i], O[vt][2 * i + 1]};
          o = o * al2;
          O[vt][2 * i] = o.x; O[vt][2 * i + 1] = o.y;
        }
    }
    const f32x2 c2 = {cexp, cexp}, m2 = {mrun, mrun};
    f32x2 ps2 = {0.f, 0.f};
    unsigned pk[2][8];
#pragma unroll
    for (int mt = 0; mt < 2; ++mt)
#pragma unroll
      for (int i = 0; i < 8; ++i) {
        f32x2 z = {S[mt][2 * i], S[mt][2 * i + 1]};
        z = z * c2 - m2;
        f32x2 pv = {__builtin_amdgcn_exp2f(z.x), __builtin_amdgcn_exp2f(z.y)};
        ps2 = ps2 + pv;
        pk[mt][i] = pk2(pv.x, pv.y);
      }
    lsum += ps2.x + ps2.y;
#pragma unroll
    for (int mt = 0; mt < 2; ++mt)
#pragma unroll
      for (int s = 0; s < 2; ++s) {
        const uint4 pu = make_uint4(pk[mt][4 * s], pk[mt][4 * s + 1], pk[mt][4 * s + 2], pk[mt][4 * s + 3]);
        const bf16x8 pf = __builtin_bit_cast(bf16x8, pu);
#pragma unroll
        for (int vt = 0; vt < 2; ++vt) {
          const unsigned char* bp = sVc + (vt * 32 + r) * 136 + (mt * 32 + 16 * s + 4 * h2) * 2;
          const uint2 lo = *(const uint2*)(bp);
          const uint2 hi = *(const uint2*)(bp + 16);
          const uint4 u = make_uint4(lo.x, lo.y, hi.x, hi.y);
          O[vt] = MFMA32(__builtin_bit_cast(bf16x8, u), pf, O[vt]);
        }
      }
    }
  }
  const float ltot = lsum + __shfl_xor(lsum, 32);
  if (MODE == 0) {
    const float lam_init = 0.8f - 0.6f * __expf(-0.3f * (float)l);
    float s01 = 0.f, s23 = 0.f;
    for (int i = 0; i < 32; ++i) {
      s01 += p.diff_lam[l * 128 + i] * p.diff_lam[l * 128 + 32 + i];
      s23 += p.diff_lam[l * 128 + 64 + i] * p.diff_lam[l * 128 + 96 + i];
    }
    const float lam = expf(s01) - expf(s23) + lam_init;
    float* sO = (float*)smem;
    const int ql = (wv & 1) * 32 + r;
    __syncthreads();
    if (mp == 1) {
      const float i1 = lam / ltot;
#pragma unroll
      for (int vt = 0; vt < 2; ++vt)
#pragma unroll
        for (int i = 0; i < 16; ++i) sO[ql * 65 + vt * 32 + crow(i, h2)] = O[vt][i] * i1;
    }
    __syncthreads();
    if (mp == 0) {
      const float i0 = 1.f / ltot;
      float ss = 0.f;
#pragma unroll
      for (int vt = 0; vt < 2; ++vt)
#pragma unroll
        for (int i = 0; i < 16; ++i) { const float o = O[vt][i] * i0 - sO[ql * 65 + vt * 32 + crow(i, h2)]; O[vt][i] = o; ss += o * o; }
      ss += __shfl_xor(ss, 32);
      const float rstd = rsqrtf(ss * (1.f / 64.f) + EPS) * (1.f - lam_init);
#pragma unroll
      for (int vt = 0; vt < 2; ++vt)
#pragma unroll
        for (int g4 = 0; g4 < 4; ++g4) {
          const int v0 = vt * 32 + 8 * g4 + 4 * h2;
          const ushort4 gt = *(const ushort4*)(P + qrow * PW + GATE + hd * 64 + v0);
          const float4 gg = *(const float4*)(p.diff_g + l * 64 + v0);
          uint2 o;
          o.x = pk2(O[vt][4 * g4 + 0] * rstd * gg.x * siluf_(bf2f(gt.x)), O[vt][4 * g4 + 1] * rstd * gg.y * siluf_(bf2f(gt.y)));
          o.y = pk2(O[vt][4 * g4 + 2] * rstd * gg.z * siluf_(bf2f(gt.z)), O[vt][4 * g4 + 3] * rstd * gg.w * siluf_(bf2f(gt.w)));
          *(uint2*)(MIX + kblk((int)qrow, hd * 64 + v0, ROWS)) = o;
        }
    }
  } else {
    const float i0 = 1.f / ltot;
#pragma unroll
    for (int vt = 0; vt < 2; ++vt)
#pragma unroll
      for (int g4 = 0; g4 < 4; ++g4) {
        const int v0 = vt * 32 + 8 * g4 + 4 * h2;
        const ushort4 gt = *(const ushort4*)(P + qrow * PW + GATE + 512 + hd * 64 + v0);
        uint2 o;
        o.x = pk2(O[vt][4 * g4 + 0] * i0 * siluf_(bf2f(gt.x)), O[vt][4 * g4 + 1] * i0 * siluf_(bf2f(gt.y)));
        o.y = pk2(O[vt][4 * g4 + 2] * i0 * siluf_(bf2f(gt.z)), O[vt][4 * g4 + 3] * i0 * siluf_(bf2f(gt.w)));
        *(uint2*)(MIX + kblk((int)qrow, 512 + hd * 64 + v0, ROWS)) = o;
      }
  }
}


using f32x4 = __attribute__((ext_vector_type(4))) float;
#define MFMA16(a, b, c) __builtin_amdgcn_mfma_f32_16x16x32_bf16((a), (b), (c), 0, 0, 0)
DI int swz(int row, int c) { return row * 128 + ((c ^ ((row >> 1) & 7)) << 4); }
DI float exps(float x) { return __builtin_amdgcn_exp2f(fminf(x, 115.f)); }
constexpr int L_CUM = 0, L_QM = 16384, L_KM = 24576, L_QS = 32768, L_KET = 40960, L_VT = 49152, L_STT = 57344, L_DEC = 65536, L_N0 = 65792, L_TOT = 66048, L_LB = 67072;

DI unsigned char* summ_ptr(const Params& p, int mx, int b, int h, int dir, int sc) {
  return p.ws + WS_SUMM + ((size_t)((((mx * NB + b) * 4 + h) * 2 + dir) * 9 + sc)) * SUMM_STRIDE;
}

struct RecRaw { uint4 a0, a1, b0, b1, c0, c1; float ig, fg; };
template <int MX>
DI RecRaw rec_load(const Params& p, int b, int h, int dir, int T0, int tid) {
  const bf16_t* P = (const bf16_t*)(p.ws + WS_P);
  const int tt = tid >> 2, k0 = (tid & 3) * 16;
  const size_t row = (size_t)b * NTOK + T0 + tt;
  const bf16_t* rp = P + row * PW;
  RecRaw w;
  if (MX == 0) {
    const int fcol = (dir ? B_FB : B_FF) + h * 64 + k0;
    w.a0 = *(const uint4*)(rp + fcol); w.a1 = *(const uint4*)(rp + fcol + 8);
    w.b0 = *(const uint4*)(rp + B_Q + h * 64 + k0); w.b1 = *(const uint4*)(rp + B_Q + h * 64 + k0 + 8);
    w.c0 = *(const uint4*)(rp + B_I + h * 64 + k0); w.c1 = *(const uint4*)(rp + B_I + h * 64 + k0 + 8);
    w.ig = 0.f; w.fg = 0.f;
  } else {
    w.a0 = *(const uint4*)(rp + D_K + h * 64 + k0); w.a1 = *(const uint4*)(rp + D_K + h * 64 + k0 + 8);
    w.b0 = *(const uint4*)(rp + D_Q + h * 64 + k0); w.b1 = *(const uint4*)(rp + D_Q + h * 64 + k0 + 8);
    w.c0 = *(const uint4*)(rp + D_V + h * 64 + k0); w.c1 = *(const uint4*)(rp + D_V + h * 64 + k0 + 8);
    const float* G = (const float*)(p.ws + WS_GATES) + row * 16;
    w.ig = G[dir * 4 + h]; w.fg = G[8 + dir * 4 + h];
  }
  return w;
}
template <int MX, bool OUT>
DI void rec_chunk(const Params& p, int l, int b, int h, int dir, int T0, unsigned char* smem, f32x4 (&St)[4], float& nst, float& dtot, int tid, const RecRaw& raw) {
  const int lane = tid & 63, w = tid >> 6, col = lane & 15, g = lane >> 4;
  const bf16_t* P = (const bf16_t*)(p.ws + WS_P);
  float* CUM = (float*)(smem + L_CUM);
  float* DEC = (float*)(smem + L_DEC);
  float* N0 = (float*)(smem + L_N0);
  float* TOT = (float*)(smem + L_TOT);
  const float* LB = (const float*)(smem + L_LB);
  const int tt = tid >> 2, grp = tid & 3, k0 = grp * 16;
  float qv[16], kin[16], vv[16];
  {
    const uint4 a0 = raw.a0, a1 = raw.a1, b0 = raw.b0, b1 = raw.b1, c0 = raw.c0, c1 = raw.c1;
    const unsigned au[8] = {a0.x, a0.y, a0.z, a0.w, a1.x, a1.y, a1.z, a1.w};
    const unsigned bu[8] = {b0.x, b0.y, b0.z, b0.w, b1.x, b1.y, b1.z, b1.w};
    const unsigned cu[8] = {c0.x, c0.y, c0.z, c0.w, c1.x, c1.y, c1.z, c1.w};
    float lf[16];
    if (MX == 0) {
#pragma unroll
      for (int i = 0; i < 8; ++i) {
#pragma unroll
        for (int hh = 0; hh < 2; ++hh) {
          const int k = 2 * i + hh;
          float z = __uint_as_float(hh ? (au[i] & 0xffff0000u) : (au[i] << 16));
          z = fminf(fmaxf(z, -30.f), 30.f);
          const float e = __expf(-z);
          const float sg = 1.f / (1.f + e);
          const float lb = LB[k0 + k];
          lf[k] = __log2f(lb + (1.f - lb) * sg);
          kin[k] = (1.f - lb) * (e * sg);
          qv[k] = __uint_as_float(hh ? (bu[i] & 0xffff0000u) : (bu[i] << 16)) * 0.125f;
          vv[k] = __uint_as_float(hh ? (cu[i] & 0xffff0000u) : (cu[i] << 16));
        }
      }
    } else {
      const float ig = raw.ig, fg = raw.fg;
      const float lfs = (fg < -20.f) ? fg * 1.4426950408889634f : -__log2f(1.f + __expf(-fg));
      const float ei = __expf(ig) * 0.125f;
#pragma unroll
      for (int i = 0; i < 8; ++i) {
#pragma unroll
        for (int hh = 0; hh < 2; ++hh) {
          const int k = 2 * i + hh;
          lf[k] = lfs;
          kin[k] = __uint_as_float(hh ? (au[i] & 0xffff0000u) : (au[i] << 16)) * ei;
          qv[k] = __uint_as_float(hh ? (bu[i] & 0xffff0000u) : (bu[i] << 16));
          vv[k] = __uint_as_float(hh ? (cu[i] & 0xffff0000u) : (cu[i] << 16));
        }
      }
    }
#pragma unroll
    for (int i = 0; i < 4; ++i) { if (MX == 0) *(float4*)(CUM + tt * 64 + k0 + 4 * i) = make_float4(lf[4 * i], lf[4 * i + 1], lf[4 * i + 2], lf[4 * i + 3]); }
    if (MX == 1 && grp == 0) CUM[tt * 64] = lf[0];
  }
  __syncthreads();
  if (MX == 1) {
    if (w == 0) {
      float x = CUM[lane * 64];
#pragma unroll
      for (int o = 1; o < 64; o <<= 1) {
        const float y = dir == 0 ? __shfl_up(x, o) : __shfl_down(x, o);
        const bool ok = dir == 0 ? (lane >= o) : (lane + o < 64);
        x += ok ? y : 0.f;
      }
      CUM[lane * 64] = x;
    }
    __syncthreads();
  } else {
    const int k = tid & 63, part = tid >> 6;
    float x[16];
    float acc = 0.f;
    if (dir == 0) {
#pragma unroll
      for (int i = 0; i < 16; ++i) { acc += CUM[(part * 16 + i) * 64 + k]; x[i] = acc; }
    } else {
#pragma unroll
      for (int i = 15; i >= 0; --i) { acc += CUM[(part * 16 + i) * 64 + k]; x[i] = acc; }
    }
    TOT[part * 64 + k] = acc;
    __syncthreads();
    float off = 0.f;
#pragma unroll
    for (int pp = 0; pp < 4; ++pp) { const bool take = dir == 0 ? (pp < part) : (pp > part); off += take ? TOT[pp * 64 + k] : 0.f; }
#pragma unroll
    for (int i = 0; i < 16; ++i) CUM[(part * 16 + i) * 64 + k] = x[i] + off;
  }
  __syncthreads();
  {
    const int mid = dir == 0 ? 31 : 32, last = dir == 0 ? 63 : 0;
    const int kvbase = k0 * 128 + (tt & 7) * 2, t3 = tt >> 3;
    float s_qm = 0.f, s_km = 0.f, s_qs = 0.f, s_ke = 0.f, s_dec = 0.f;
    if (MX == 1) {
      const float c = CUM[tt * 64], cm = CUM[mid * 64], cl = CUM[last * 64];
      s_qm = exps(c - cm); s_km = exps(cm - c); s_qs = exps(c); s_ke = exps(cl - c); s_dec = exps(cl);
    }
    unsigned qm[8], km[8], qs[8];
#pragma unroll
    for (int i = 0; i < 8; ++i) {
      float r_qm[2], r_km[2], r_qs[2];
#pragma unroll
      for (int hh = 0; hh < 2; ++hh) {
        const int k = 2 * i + hh;
        float e_qm, e_km, e_qs, e_ke, e_dec;
        if (MX == 1) { e_qm = s_qm; e_km = s_km; e_qs = s_qs; e_ke = s_ke; e_dec = s_dec; }
        else {
          const float c = CUM[tt * 64 + k0 + k], cm = CUM[mid * 64 + k0 + k], cl = CUM[last * 64 + k0 + k];
          e_qm = exps(c - cm); e_km = exps(cm - c); e_qs = exps(c); e_ke = exps(cl - c); e_dec = (tt == 0) ? exps(cl) : 0.f;
        }
        r_qm[hh] = qv[k] * e_qm;
        r_km[hh] = kin[k] * e_km;
        r_qs[hh] = qv[k] * e_qs;
        const float ke = kin[k] * e_ke;
        const int toff = kvbase + k * 128 + ((t3 ^ ((k >> 1) & 7)) << 4);
        *(bf16_t*)(smem + L_KET + toff) = f2bf(ke);
        *(bf16_t*)(smem + L_VT + toff) = f2bf(vv[k]);
        if (tt == 0) DEC[k0 + k] = e_dec;
      }
      qm[i] = pk2(r_qm[0], r_qm[1]); km[i] = pk2(r_km[0], r_km[1]); qs[i] = pk2(r_qs[0], r_qs[1]);
    }
    if (OUT) {
      *(uint4*)(smem + L_QM + swz(tt, grp * 2)) = make_uint4(qm[0], qm[1], qm[2], qm[3]);
      *(uint4*)(smem + L_QM + swz(tt, grp * 2 + 1)) = make_uint4(qm[4], qm[5], qm[6], qm[7]);
      *(uint4*)(smem + L_KM + swz(tt, grp * 2)) = make_uint4(km[0], km[1], km[2], km[3]);
      *(uint4*)(smem + L_KM + swz(tt, grp * 2 + 1)) = make_uint4(km[4], km[5], km[6], km[7]);
      *(uint4*)(smem + L_QS + swz(tt, grp * 2)) = make_uint4(qs[0], qs[1], qs[2], qs[3]);
      *(uint4*)(smem + L_QS + swz(tt, grp * 2 + 1)) = make_uint4(qs[4], qs[5], qs[6], qs[7]);
    }
  }
  __syncthreads();
  if (OUT) {
    const int t = 16 * w + col;
    bf16_t* MIX = (bf16_t*)(p.ws + WS_HM);
    const size_t orow = (size_t)b * NTOK + T0 + t;
    const int cb = (MX ? 768 : 256) + h * 64;
    const bf16_t* prow = P + orow * PW;
    f32x4 S[4];
#pragma unroll
    for (int a = 0; a < 4; ++a) {
      S[a] = f32x4{0.f, 0.f, 0.f, 0.f};
      const bool need = dir == 0 ? (a <= w) : (a >= w);
      if (need) {
#pragma unroll
        for (int ks = 0; ks < 2; ++ks) {
          const bf16x8 fa = *(const bf16x8*)(smem + L_KM + swz(16 * a + col, ks * 4 + g));
          const bf16x8 fb = *(const bf16x8*)(smem + L_QM + swz(t, ks * 4 + g));
          S[a] = MFMA16(fa, fb, S[a]);
        }
        if (a == w) {
#pragma unroll
          for (int j = 0; j < 4; ++j) { const bool keep = dir == 0 ? (4 * g + j <= col) : (4 * g + j >= col); if (!keep) S[a][j] = 0.f; }
        }
      }
    }
    float den = 0.f;
    if (MX == 1) {
#pragma unroll
      for (int a = 0; a < 4; ++a)
#pragma unroll
        for (int j = 0; j < 4; ++j) den += S[a][j];
      const uint4 q0 = *(const uint4*)(smem + L_QS + swz(t, 2 * g)), q1 = *(const uint4*)(smem + L_QS + swz(t, 2 * g + 1));
      const unsigned qu[8] = {q0.x, q0.y, q0.z, q0.w, q1.x, q1.y, q1.z, q1.w};
#pragma unroll
      for (int i = 0; i < 8; ++i) {
        den += __uint_as_float(qu[i] << 16) * N0[16 * g + 2 * i] + __uint_as_float(qu[i] & 0xffff0000u) * N0[16 * g + 2 * i + 1];
      }
      den += __shfl_xor(den, 16);
      den += __shfl_xor(den, 32);
    }
    f32x4 O[4];
#pragma unroll
    for (int a = 0; a < 4; ++a) O[a] = f32x4{0.f, 0.f, 0.f, 0.f};
#pragma unroll
    for (int kp = 0; kp < 2; ++kp) {
      const bool need = dir == 0 ? (2 * kp <= w) : (2 * kp + 1 >= w);
      if (need) {
        const uint4 u = make_uint4(pk2(S[2 * kp][0], S[2 * kp][1]), pk2(S[2 * kp][2], S[2 * kp][3]), pk2(S[2 * kp + 1][0], S[2 * kp + 1][1]), pk2(S[2 * kp + 1][2], S[2 * kp + 1][3]));
        const bf16x8 pf = __builtin_bit_cast(bf16x8, u);
#pragma unroll
        for (int a = 0; a < 4; ++a) {
          const int vr = 16 * a + col;
          const uint2 lo = *(const uint2*)(smem + L_VT + swz(vr, 4 * kp + (g >> 1)) + (g & 1) * 8);
          const uint2 hi = *(const uint2*)(smem + L_VT + swz(vr, 4 * kp + 2 + (g >> 1)) + (g & 1) * 8);
          const uint4 va = make_uint4(lo.x, lo.y, hi.x, hi.y);
          O[a] = MFMA16(__builtin_bit_cast(bf16x8, va), pf, O[a]);
        }
      }
    }
#pragma unroll
    for (int ks = 0; ks < 2; ++ks) {
      const bf16x8 fb = *(const bf16x8*)(smem + L_QS + swz(t, ks * 4 + g));
#pragma unroll
      for (int a = 0; a < 4; ++a) {
        const bf16x8 fa = *(const bf16x8*)(smem + L_STT + swz(16 * a + col, ks * 4 + g));
        O[a] = MFMA16(fa, fb, O[a]);
      }
    }
    if (MX == 1) {
      const float inv = 1.f / fmaxf(fabsf(den), 1.f);
#pragma unroll
      for (int a = 0; a < 4; ++a)
#pragma unroll
        for (int j = 0; j < 4; ++j) O[a][j] *= inv;
    }
    if (dir == 0) {
#pragma unroll
      for (int a = 0; a < 4; ++a) *(uint2*)(MIX + kblk((int)orow, cb + 16 * a + 4 * g, ROWS)) = make_uint2(pk2(O[a][0], O[a][1]), pk2(O[a][2], O[a][3]));
    } else {
      float ss = 0.f;
#pragma unroll
      for (int a = 0; a < 4; ++a) {
        const uint2 u = *(const uint2*)(MIX + kblk((int)orow, cb + 16 * a + 4 * g, ROWS));
        O[a][0] += __uint_as_float(u.x << 16); O[a][1] += __uint_as_float(u.x & 0xffff0000u);
        O[a][2] += __uint_as_float(u.y << 16); O[a][3] += __uint_as_float(u.y & 0xffff0000u);
#pragma unroll
        for (int j = 0; j < 4; ++j) ss += O[a][j] * O[a][j];
      }
      ss += __shfl_xor(ss, 16);
      ss += __shfl_xor(ss, 32);
      const float rstd = rsqrtf(ss * (1.f / 64.f) + EPS);
      const float* gvec = (MX ? p.ml_g : p.hg_g) + l * 64;
#pragma unroll
      for (int a = 0; a < 4; ++a) {
        const int v0 = 16 * a + 4 * g;
        const uint2 gt = *(const uint2*)(prow + GATE + cb + v0);
        const float4 gg = *(const float4*)(gvec + v0);
        float y0 = O[a][0] * rstd * gg.x * siluf_(__uint_as_float(gt.x << 16));
        float y1 = O[a][1] * rstd * gg.y * siluf_(__uint_as_float(gt.x & 0xffff0000u));
        float y2 = O[a][2] * rstd * gg.z * siluf_(__uint_as_float(gt.y << 16));
        float y3 = O[a][3] * rstd * gg.w * siluf_(__uint_as_float(gt.y & 0xffff0000u));
        if (MX == 1) {
          const uint2 og = *(const uint2*)(prow + D_OG + h * 64 + v0);
          y0 *= sigmoidf_(__uint_as_float(og.x << 16)); y1 *= sigmoidf_(__uint_as_float(og.x & 0xffff0000u));
          y2 *= sigmoidf_(__uint_as_float(og.y << 16)); y3 *= sigmoidf_(__uint_as_float(og.y & 0xffff0000u));
        }
        *(uint2*)(MIX + kblk((int)orow, cb + v0, ROWS)) = make_uint2(pk2(y0, y1), pk2(y2, y3));
      }
    }
  }
  {
#pragma unroll
    for (int c = 0; c < 4; ++c) {
      const float d = DEC[16 * c + col];
#pragma unroll
      for (int j = 0; j < 4; ++j) St[c][j] *= d;
    }
#pragma unroll
    for (int ks = 0; ks < 2; ++ks) {
      const bf16x8 fa = *(const bf16x8*)(smem + L_VT + swz(16 * w + col, ks * 4 + g));
#pragma unroll
      for (int c = 0; c < 4; ++c) {
        const bf16x8 fb = *(const bf16x8*)(smem + L_KET + swz(16 * c + col, ks * 4 + g));
        St[c] = MFMA16(fa, fb, St[c]);
      }
    }
    if (tid < 64) {
      const float d = DEC[tid];
      dtot *= d;
      if (MX == 1) {
        float s = 0.f;
#pragma unroll
        for (int cc = 0; cc < 8; ++cc) {
          const uint4 u = *(const uint4*)(smem + L_KET + swz(tid, cc));
          s += __uint_as_float(u.x << 16) + __uint_as_float(u.x & 0xffff0000u) + __uint_as_float(u.y << 16) + __uint_as_float(u.y & 0xffff0000u)
             + __uint_as_float(u.z << 16) + __uint_as_float(u.z & 0xffff0000u) + __uint_as_float(u.w << 16) + __uint_as_float(u.w & 0xffff0000u);
        }
        nst = d * nst + s;
      }
    }
    __syncthreads();
    if (OUT) {
#pragma unroll
      for (int c = 0; c < 4; ++c)
#pragma unroll
        for (int j = 0; j < 4; ++j) {
          const int v = 16 * w + 4 * g + j, k = 16 * c + col;
          *(bf16_t*)(smem + L_STT + swz(v, k >> 3) + (k & 7) * 2) = f2bf(St[c][j]);
        }
      if (MX == 1 && tid < 64) N0[tid] = nst;
    }
  }
}

DI void rec_setup_lb(const Params& p, int l, int h, unsigned char* smem, int tid) {
  float* LB = (float*)(smem + L_LB);
  __syncthreads();
  if (tid < 64) LB[tid] = (l == 1) ? sigmoidf_(p.hg_lb[256 + h * 64 + tid] - p.hg_lb[h * 64 + tid]) : 0.f;
  __syncthreads();
}

template <int MX>
DI void rec_summary(const Params& p, int l, int b, int h, int dir, int sc, unsigned char* smem) {
  const int tid = ltid_w(p.wave);
  const int lane = tid & 63, w = tid >> 6, col = lane & 15, g = lane >> 4;
  if (MX == 0) rec_setup_lb(p, l, h, smem, tid); else __syncthreads();
  f32x4 St[4];
#pragma unroll
  for (int c = 0; c < 4; ++c) St[c] = f32x4{0.f, 0.f, 0.f, 0.f};
  float nst = 0.f, dtot = 1.f;
  RecRaw raw = rec_load<MX>(p, b, h, dir, sc * 256 + (dir == 0 ? 0 : 3) * 64, tid);
#pragma unroll 1
  for (int ci = 0; ci < 4; ++ci) {
    const int c = dir == 0 ? ci : 3 - ci;
    const int cn = dir == 0 ? (ci < 3 ? ci + 1 : ci) : (ci < 3 ? 2 - ci : 0);
    const RecRaw nxt = rec_load<MX>(p, b, h, dir, sc * 256 + cn * 64, tid);
    rec_chunk<MX, false>(p, l, b, h, dir, sc * 256 + c * 64, smem, St, nst, dtot, tid, raw);
    raw = nxt;
  }
  unsigned char* sp = summ_ptr(p, MX, b, h, dir, sc);
  float* E = (float*)sp;
#pragma unroll
  for (int c = 0; c < 4; ++c)
#pragma unroll
    for (int j = 0; j < 4; ++j) E[(16 * w + 4 * g + j) * 64 + 16 * c + col] = St[c][j];
  if (tid < 64) { ((float*)(sp + 16384))[tid] = dtot; ((float*)(sp + 16640))[tid] = nst; }
}

struct SumRegs { f32x4 E0, E1, E2, E3, d; float nd, nn; };
template <int MX>
DI SumRegs rec_ldsum(const Params& p, int b, int h, int dir, int i, int w, int g, int col, int tid) {
  const int s2 = dir == 0 ? i : (i == 0 ? 0 : 9 - i);
  const unsigned char* sp = summ_ptr(p, MX, b, h, dir, s2);
  const float* E = (const float*)sp + (16 * w + 4 * g) * 64 + col;
  const float* dd = (const float*)(sp + 16384);
  SumRegs r;
  r.d = f32x4{dd[col], dd[16 + col], dd[32 + col], dd[48 + col]};
  r.E0 = f32x4{E[0], E[64], E[128], E[192]};
  r.E1 = f32x4{E[16], E[64 + 16], E[128 + 16], E[192 + 16]};
  r.E2 = f32x4{E[32], E[64 + 32], E[128 + 32], E[192 + 32]};
  r.E3 = f32x4{E[48], E[64 + 48], E[128 + 48], E[192 + 48]};
  r.nd = 0.f; r.nn = 0.f;
  if (MX == 1 && tid < 64) { r.nd = dd[tid]; r.nn = ((const float*)(sp + 16640))[tid]; }
  return r;
}

template <int MX>
DI void rec_output(const Params& p, int l, int b, int h, int sc, unsigned char* smem) {
  const int tid = ltid_w(p.wave);
  const int lane = tid & 63, w = tid >> 6, col = lane & 15, g = lane >> 4;
  if (MX == 0) rec_setup_lb(p, l, h, smem, tid);
#pragma unroll 1
  for (int dir = 0; dir < 2; ++dir) {
    f32x4 St[4];
#pragma unroll
    for (int c = 0; c < 4; ++c) St[c] = f32x4{0.f, 0.f, 0.f, 0.f};
    float nst = 0.f, dtot = 1.f;
    const int npre = dir == 0 ? sc : (sc == 0 ? 0 : 1 + (8 - sc));
    SumRegs cur = rec_ldsum<MX>(p, b, h, dir, 0, w, g, col, tid);
#pragma unroll 1
    for (int i = 0; i < npre; ++i) {
      const SumRegs nxt = rec_ldsum<MX>(p, b, h, dir, (i + 1 < npre) ? i + 1 : i, w, g, col, tid);
      St[0] = cur.d[0] * St[0] + cur.E0;
      St[1] = cur.d[1] * St[1] + cur.E1;
      St[2] = cur.d[2] * St[2] + cur.E2;
      St[3] = cur.d[3] * St[3] + cur.E3;
      if (MX == 1 && tid < 64) nst = cur.nd * nst + cur.nn;
      cur = nxt;
    }
    __syncthreads();
#pragma unroll
    for (int c = 0; c < 4; ++c)
#pragma unroll
      for (int j = 0; j < 4; ++j) {
        const int v = 16 * w + 4 * g + j, k = 16 * c + col;
        *(bf16_t*)(smem + L_STT + swz(v, k >> 3) + (k & 7) * 2) = f2bf(St[c][j]);
      }
    if (MX == 1 && tid < 64) ((float*)(smem + L_N0))[tid] = nst;
    RecRaw raw = rec_load<MX>(p, b, h, dir, sc * 256 + (dir == 0 ? 0 : 3) * 64, tid);
#pragma unroll 1
    for (int ci = 0; ci < 4; ++ci) {
      const int c = dir == 0 ? ci : 3 - ci;
      const int cn = dir == 0 ? (ci < 3 ? ci + 1 : ci) : (ci < 3 ? 2 - ci : 0);
      const RecRaw nxt = rec_load<MX>(p, b, h, dir, sc * 256 + cn * 64, tid);
      rec_chunk<MX, true>(p, l, b, h, dir, sc * 256 + c * 64, smem, St, nst, dtot, tid, raw);
      raw = nxt;
    }
  }
}

typedef __attribute__((address_space(3))) int lds_int;
DI int next_item(unsigned* ctr, volatile lds_int* slot) {
  __syncthreads();
  if (threadIdx.x == 0) *slot = (int)__hip_atomic_fetch_add(ctr, 1u, __ATOMIC_RELAXED, __HIP_MEMORY_SCOPE_AGENT);
  __syncthreads();
  return *slot;
}
DI void ph_mixers1(const Params& p_in, int l, unsigned char* smem, volatile lds_int* slot) {
  const int nfill = (l == 0) ? WT_TILES / 8 : 0;
  const int total = 64 + 1152 + 576 + 576 + nfill;
  unsigned* ctr = (unsigned*)(p_in.ws + WS_CTL + 13824) + (l * 2 + 0);
  for (;;) {
    const int it = next_item(ctr, slot);
    if (it >= total) break;
    Params p = p_in;
    asm volatile("" : "+s"(p.ws));
    if (it < 64) {
      const int mx = it >> 5, h = it & 3, b = (it >> 2) & 7;
      if (l == 0) { if (mx == 0) rec_output<0>(p, l, b, h, 0, smem); else rec_output<1>(p, l, b, h, 0, smem); }
    } else if (it < 1216) { const int r = it - 64; const int qb = r % 36, bh = r / 36; if (!(l == 1 && qb < 4)) attn_mfma<0>(p, l, bh >> 2, bh & 3, qb, smem); }
    else if (it >= 64 + 1152 + 576 + 576) {
      const int f = it - (64 + 1152 + 576 + 576);
      const int tid = ltid_w(p.wave);
      for (int u = 0; u < 8; ++u) wt_tile(p, 1, f * 8 + u, smem, tid);
    } else {
      int r = it - 1216; const int mx = r / 576; r %= 576;
      const int sc = r % 9; r /= 9; const int dir = r & 1, h = (r >> 1) & 3, b = r >> 3;
      const bool last = dir == 0 ? (sc == 8) : (sc == 1);
      if (!last) { if (mx == 0) rec_summary<0>(p, l, b, h, dir, sc, smem); else rec_summary<1>(p, l, b, h, dir, sc, smem); }
    }
  }
}
DI void ph_mixers2(const Params& p_in, int l, unsigned char* smem, volatile lds_int* slot) {
  const int total = 512 + 576;
  unsigned* ctr = (unsigned*)(p_in.ws + WS_CTL + 13824) + (l * 2 + 1);
  for (;;) {
    const int it = next_item(ctr, slot);
    if (it >= total) break;
    Params p = p_in;
    asm volatile("" : "+s"(p.ws));
    if (it < 512) {
      int r = it; const int mx = r >> 8; r &= 255;
      const int sc = 1 + (r & 7); r >>= 3; const int h = r & 3, b = r >> 2;
      if (mx == 0) rec_output<0>(p, l, b, h, sc, smem); else rec_output<1>(p, l, b, h, sc, smem);
    } else { const int r = it - 512; const int qb = r % 18, bh = r / 18; if (!(l == 1 && qb < 2)) attn_mfma<1>(p, l, bh >> 2, bh & 3, qb, smem); }
  }
}

DI void ph_final(const Params& p, int bid, int nb) {
  const int tid_ = ltid_w(p.wave); const int lane = tid_ & 63, w = tid_ >> 6;
  for (int it = bid; it < NB * NLAT / 8; it += nb) {
    float4 v[2][4];
#pragma unroll
    for (int rr = 0; rr < 2; ++rr) {
      const float* rp = p.out + (size_t)(it * 8 + rr * 4 + w) * DM;
#pragma unroll
      for (int i = 0; i < 4; ++i) v[rr][i] = *(const float4*)(rp + (i * 64 + lane) * 4);
    }
#pragma unroll
    for (int rr = 0; rr < 2; ++rr) {
      float* rp = p.out + (size_t)(it * 8 + rr * 4 + w) * DM;
      float ss = 0.f;
#pragma unroll
      for (int i = 0; i < 4; ++i) ss += v[rr][i].x * v[rr][i].x + v[rr][i].y * v[rr][i].y + v[rr][i].z * v[rr][i].z + v[rr][i].w * v[rr][i].w;
      ss = wave_sum(ss);
      const float rstd = rsqrtf(ss * (1.f / DM) + EPS);
#pragma unroll
      for (int i = 0; i < 4; ++i) {
        const int j = (i * 64 + lane) * 4;
        const float4 gg = *(const float4*)(p.final_g + j);
        float4 o;
        o.x = v[rr][i].x * rstd * gg.x; o.y = v[rr][i].y * rstd * gg.y; o.z = v[rr][i].z * rstd * gg.z; o.w = v[rr][i].w * rstd * gg.w;
        *(float4*)(rp + j) = o;
      }
    }
  }
}

constexpr int N_PHASES = 14;
#define XB_TMO      128
#define XB_XCNT(j)  (256  + 64 * (j))
#define XB_XSUB(j)  (1280 + 64 * (j))
#define XB_XGEN(j)  (2304 + 64 * (j))
#define XB_TOP      3328
#define XB_TOPGEN   3392
#define XCD_BAR_WORDS 3456
#define XB_SPIN_CAP (1u << 22)
DI unsigned xb_ld(unsigned* p) { return __hip_atomic_load(p, __ATOMIC_RELAXED, __HIP_MEMORY_SCOPE_AGENT); }
DI unsigned xb_add(unsigned* p, unsigned v) { return __hip_atomic_fetch_add(p, v, __ATOMIC_RELAXED, __HIP_MEMORY_SCOPE_AGENT); }
DI unsigned xb_xcc_id() { return (unsigned)__builtin_amdgcn_s_getreg((3 << 11) | 20) & 0xFu; }
#define XB_SPIN(cond, bar) do { unsigned _sp = 0; while (cond) { __builtin_amdgcn_s_sleep(1); \
    if ((++_sp & 255u) == 0u) { if (xb_ld(&(bar)[XB_TMO])) break; if (_sp > XB_SPIN_CAP) { atomicAdd(&(bar)[XB_TMO], 1u); break; } } } } while (0)
#define LAS __attribute__((address_space(3)))
struct XcdBarrier { unsigned* bar; volatile LAS unsigned* st; };
DI XcdBarrier xcd_barrier_post(unsigned* bar, volatile LAS unsigned* st) {
  XcdBarrier b; b.bar = bar; b.st = st;
  if (threadIdx.x == 0) { const unsigned x = xb_xcc_id(); st[2] = x; (void)xb_add(&bar[XB_XCNT(x)], 1u); }
  return b;
}
DI void xcd_barrier_complete(unsigned* bar, unsigned x, unsigned& nloc, unsigned& nx) {
  const unsigned G = gridDim.x;
  unsigned sum, cnt, mine, sp = 0u;
  for (;;) {
    sum = 0u; cnt = 0u; mine = 0u;
#pragma unroll
    for (unsigned j = 0; j < 16; ++j) { const unsigned c = xb_ld(&bar[XB_XCNT(j)]); sum += c; cnt += (c > 0u) ? 1u : 0u; mine = (j == x) ? c : mine; }
    if (sum == G) break;
    __builtin_amdgcn_s_sleep(1);
    if ((++sp & 255u) == 0u) { if (xb_ld(&bar[XB_TMO])) break; if (sp > XB_SPIN_CAP) { atomicAdd(&bar[XB_TMO], 1u); break; } }
  }
  nloc = mine > 0u ? mine : 1u; nx = cnt > 0u ? cnt : 1u;
}
template <bool FIRST>
DI void xcd_barrier(XcdBarrier& b) {
  asm volatile("s_waitcnt vmcnt(0)" ::: "memory");
  __syncthreads();
  if (threadIdx.x == 0) {
    unsigned* bar = b.bar;
    asm volatile("" : "+s"(bar));
    __builtin_amdgcn_s_waitcnt(0);
    const unsigned bx = b.st[2];
    if (FIRST) { unsigned n0, n1; xcd_barrier_complete(bar, bx, n0, n1); b.st[0] = n0; b.st[1] = n1; }
    const unsigned nloc = b.st[0], nx = b.st[1];
    const unsigned old = xb_add(&bar[XB_XSUB(bx)], 1u);
    const unsigned gen = old / nloc;
    if (old + 1u == (gen + 1u) * nloc) {
      __builtin_amdgcn_fence(__ATOMIC_RELEASE, "agent");
      asm volatile("s_waitcnt vmcnt(0)" ::: "memory");
      const unsigned og = xb_add(&bar[XB_TOP], 1u);
      const unsigned tg = og / nx;
      if (og + 1u == (tg + 1u) * nx) xb_add(&bar[XB_TOPGEN], 1u);
      else XB_SPIN(xb_ld(&bar[XB_TOPGEN]) == tg, bar);
      __builtin_amdgcn_fence(__ATOMIC_ACQUIRE, "agent");
      xb_add(&bar[XB_XGEN(bx)], 1u);
      asm volatile("s_waitcnt vmcnt(0)" ::: "memory");
    } else {
      XB_SPIN(xb_ld(&bar[XB_XGEN(bx)]) == gen, bar);
      __builtin_amdgcn_fence(__ATOMIC_ACQUIRE, "agent");
      asm volatile("s_waitcnt vmcnt(0)" ::: "memory");
    }
  }
  __syncthreads();
}
#ifndef PMASK
#define PMASK 0xff
#endif
#ifndef DUP
#define DUP 0
#endif
#ifndef GWM
#define GWM 4
#endif
__global__ void __launch_bounds__(256, 2) mk_fwd(Params p_in) {
  __shared__ __attribute__((aligned(16))) unsigned char smem[SMEM_BYTES];
  const int bid = blockIdx.x, nb = gridDim.x;
  const int lo = p_in.ph_lo, hi = p_in.ph_hi;
  Params p = p_in;
  p.wave = __builtin_amdgcn_readfirstlane((int)(threadIdx.x >> 6));
#define IN(k) (lo <= (k) && (k) < hi)
#define SEAM(k) do { if (IN(k) && IN((k) + 1)) xcd_barrier<false>(xbar); } while (0)
  __shared__ unsigned xb_words[4];
  __shared__ int q_slot;
  XcdBarrier xbar = xcd_barrier_post((unsigned*)(p.ws + WS_CTL), (volatile LAS unsigned*)&xb_words);
  if (p.ph_lo < 0) cg::this_grid().sync();
  if (IN(0)) { if (PMASK & 1) ph_prep(p, smem, bid, nb); }
  if (IN(0) && IN(1)) xcd_barrier<true>(xbar);
#pragma unroll
  for (int l = 0; l < 2; ++l) {
    const int base = 1 + 6 * l;
    Params q = p;
    asm volatile("" : "+s"(q.ws), "+s"(q.out));
    if (IN(base + 0)) { ph_norm(q, l, bid, nb); if ((DUP & 2) && l == 0) ph_norm(q, l, bid, nb); }
    SEAM(base + 0);
    if (IN(base + 1)) {
      if (PMASK & 2) {
        EpiInM<GWM> e{(bf16_t*)(q.ws + WS_P), (float*)(q.ws + WS_GATES), q.b_in + (size_t)l * PW, (const float2*)(q.ws + WS_ROPE), (const float2*)(q.ws + WS_ROPE) + 64 * 8, (bf16_t*)(q.ws + WS_VTA), (bf16_t*)(q.ws + WS_VTC), smem};
        gemm_mfma<GWM>((const bf16_t*)(q.ws + WS_HM), (const bf16_t*)(q.ws + WS_WINT) + (size_t)l * PWP * DM, ROWS, PWP, ROWS / (GWM * 64), PWP / 128, smem, bid, nb, q.wave, e);
        if ((DUP & 4) && l == 0) gemm_mfma<GWM>((const bf16_t*)(q.ws + WS_HM), (const bf16_t*)(q.ws + WS_WINT) + (size_t)l * PWP * DM, ROWS, PWP, ROWS / (GWM * 64), PWP / 128, smem, bid, nb, q.wave, e);
        if ((DUP & 64) && l == 0) { EpiNull<GWM> en{(float*)(q.ws + WS_CTL + 128)}; gemm_mfma<GWM>((const bf16_t*)(q.ws + WS_HM), (const bf16_t*)(q.ws + WS_WINT) + (size_t)l * PWP * DM, ROWS, PWP, ROWS / (GWM * 64), PWP / 128, smem, bid, nb, q.wave, en); }
      }
    }
    SEAM(base + 1);
    if (IN(base + 2)) { if (PMASK & 4) ph_mixers1(q, l, smem, (volatile lds_int*)&q_slot); if ((DUP & 8) && l == 0) ph_mixers1(q, l, smem, (volatile lds_int*)&q_slot); }
    SEAM(base + 2);
    if (IN(base + 3)) { if (PMASK & 4) ph_mixers2(q, l, smem, (volatile lds_int*)&q_slot); if ((DUP & 16) && l == 0) ph_mixers2(q, l, smem, (volatile lds_int*)&q_slot); }
    SEAM(base + 3);
    if (IN(base + 4) && IN(base + 5)) {}
    if (IN(base + 5)) {
      if (PMASK & 8) {
        EpiOutM<4> e{&q, l, (const float*)(q.ws + WS_MOD), smem, 1};
        gemm_mfma<4>((const bf16_t*)(q.ws + WS_HM), (const bf16_t*)(q.ws + WS_WOUTT) + (size_t)l * DM * DM, ROWS, DM, 64, DM / 128, smem, bid, nb, q.wave, e);
        if (l == 0) {
          EpiOutM<2> e2{&q, l, (const float*)(q.ws + WS_MOD), smem, 2};
          gemm_mfma<2>((const bf16_t*)(q.ws + WS_HM), (const bf16_t*)(q.ws + WS_WOUTT) + (size_t)l * DM * DM, ROWS, DM, 16, DM / 128, smem, bid, nb, q.wave, e2);
        }
      }
    }
    SEAM(base + 5);
  }
  if (IN(13)) ph_final(p, bid, nb);
#undef IN
#undef SEAM
}

extern "C" void kernel_launch(void* const* d_in, const int* in_sizes, int n_in, void* d_out, int out_size, void* d_ws, size_t ws_size, hipStream_t stream) {
  static int grid_blocks = 0;
  if (!grid_blocks) {
    int dev = 0, cus = 0, per_cu = 0;
    hipGetDevice(&dev);
    hipDeviceGetAttribute(&cus, hipDeviceAttributeMultiprocessorCount, dev);
    hipOccupancyMaxActiveBlocksPerMultiprocessor(&per_cu, mk_fwd, 256, 0);
    if (per_cu < 1) per_cu = 1;
    if (per_cu > 4) per_cu = 4;
    grid_blocks = cus * per_cu;
    if (ws_size < WS_END) fprintf(stderr, "kernel_launch: workspace too small: %zu < %zu\n", ws_size, (size_t)WS_END);
  }
  Params p{};
  p.x = (const float*)d_in[0]; p.c = (const float*)d_in[1]; p.ctx = (const float*)d_in[2]; p.c_ctx = (const float*)d_in[3];
  p.w_mod = (const float*)d_in[4]; p.b_mod = (const float*)d_in[5]; p.norm_g = (const float*)d_in[6]; p.w_in = (const float*)d_in[7];
  p.b_in = (const float*)d_in[8]; p.diff_lam = (const float*)d_in[9]; p.diff_g = (const float*)d_in[10]; p.hg_lb = (const float*)d_in[11];
  p.hg_g = (const float*)d_in[12]; p.sw_sink = (const float*)d_in[13]; p.ml_g = (const float*)d_in[14]; p.w_out = (const float*)d_in[15];
  p.final_g = (const float*)d_in[16];
  p.out = (float*)d_out; p.ws = (unsigned char*)d_ws;
#if N_LAUNCH_MODE == 1
  hipMemsetAsync((unsigned char*)d_ws + WS_CTL, 0, 16384, stream);
  p.ph_lo = 0; p.ph_hi = N_PHASES;
  void* args[] = {&p};
  hipError_t e = hipLaunchCooperativeKernel((void*)mk_fwd, dim3(grid_blocks), dim3(256), args, 0, stream);
  if (e != hipSuccess) fprintf(stderr, "cooperative launch failed: %s (grid %d)\n", hipGetErrorString(e), grid_blocks);
#else
  for (int ph = 0; ph < N_PHASES; ++ph) {
    p.ph_lo = ph; p.ph_hi = ph + 1;
    hipLaunchKernelGGL(mk_fwd, dim3(grid_blocks), dim3(256), 0, stream, p);
  }
#endif
}
```

```cpp
#include <hip/hip_runtime.h>
#include <hip/hip_cooperative_groups.h>
#include <cstdio>
namespace cg = cooperative_groups;

typedef unsigned short bf16_t;
#define DI __device__ __forceinline__

#ifndef N_LAUNCH_MODE
#define N_LAUNCH_MODE 1
#endif

constexpr int DM = 1024, NB = 8, NLAT = 2048, NCTX = 256, NTOK = 2304, ROWS = NB * NTOK;
constexpr int PW = 4368, PWP = 4480;
constexpr int A_Q = 0, A_K = 256, A_V = 512, B_Q = 768, B_FF = 1024, B_FB = 1280, B_I = 1536;
constexpr int C_Q = 1792, C_K = 2048, C_V = 2176, D_Q = 2304, D_K = 2560, D_V = 2816, D_G = 3072, D_OG = 3088, GATE = 3344;
constexpr float EPS = 1e-6f;

constexpr size_t WS_WINT = 0;
constexpr size_t WS_WOUTT = WS_WINT + (size_t)2 * PWP * DM * 2;
constexpr size_t WS_MOD = WS_WOUTT + (size_t)2 * DM * DM * 2;
constexpr size_t WS_ROPE = WS_MOD + (size_t)2 * 9 * 3072 * 4;
constexpr size_t WS_XRC = WS_ROPE + 65536;
constexpr size_t WS_HM = WS_XRC + (size_t)NB * NCTX * DM * 4;
constexpr size_t WS_P = WS_HM + (size_t)ROWS * DM * 2;
constexpr size_t WS_GATES = WS_P + (size_t)ROWS * PW * 2;
constexpr size_t SUMM_STRIDE = 64 * 64 * 4 + 256 + 256;
constexpr size_t WS_SUMM = WS_GATES + (size_t)ROWS * 16 * 4;
constexpr size_t WS_VTA = WS_SUMM + (size_t)2 * NB * 4 * 2 * 9 * SUMM_STRIDE;
constexpr size_t WS_VTC = WS_VTA + (size_t)NB * 4 * 64 * NTOK * 2;
constexpr size_t WS_CTL = WS_VTC + (size_t)NB * 2 * 64 * NTOK * 2;
constexpr size_t WS_END = WS_CTL + 16384;

struct Params {
  const float *x, *c, *ctx, *c_ctx, *w_mod, *b_mod, *norm_g, *w_in, *b_in, *diff_lam, *diff_g, *hg_lb, *hg_g, *sw_sink, *ml_g, *w_out, *final_g;
  float* out;
  unsigned char* ws;
  int ph_lo, ph_hi;
  int wave, pad;
};

DI int ltid_w(int wave) { int t; asm volatile("v_mbcnt_lo_u32_b32 %0, -1, 0\n\tv_mbcnt_hi_u32_b32 %0, -1, %0" : "=v"(t)); return (wave << 6) | t; }
DI size_t kblk(int row, int col, int nrows) { return ((size_t)(col >> 5) * nrows + row) * 32 + (col & 31); }
DI float bf2f(bf16_t v) { return __uint_as_float(((unsigned)v) << 16); }
typedef __bf16 hwbf16x2 __attribute__((ext_vector_type(2)));
typedef float hwf32x2 __attribute__((ext_vector_type(2)));
DI unsigned pk2(float a, float b) { hwf32x2 f = {a, b}; hwbf16x2 r = __builtin_convertvector(f, hwbf16x2); return __builtin_bit_cast(unsigned, r); }
DI bf16_t f2bf(float f) { return (bf16_t)(pk2(f, 0.f) & 0xffffu); }
DI float sigmoidf_(float z) { return 1.f / (1.f + __expf(-z)); }
DI float siluf_(float z) { return z / (1.f + __expf(-z)); }
DI float wave_sum(float v) {
#pragma unroll
  for (int o = 32; o >= 1; o >>= 1) v += __shfl_xor(v, o);
  return v;
}

constexpr int SMEM_BYTES = 72 * 1024;

DI void wt_tile(const Params& p, int l, int idx, unsigned char* smem, int tid) {
  float* tile = (float*)smem;
  const bool isin = idx < 16 * 70;
  int r = isin ? idx : idx - 16 * 70;
  const int NT = isin ? 70 : 16;
  const int kt = r / NT, nt = r % NT;
  const int Nsrc = isin ? PW : DM;
  const float* src = isin ? p.w_in + (size_t)l * DM * PW : p.w_out + (size_t)l * DM * DM;
  bf16_t* dst = isin ? (bf16_t*)(p.ws + WS_WINT) + (size_t)l * PWP * DM : (bf16_t*)(p.ws + WS_WOUTT) + (size_t)l * DM * DM;
  __syncthreads();
#pragma unroll
  for (int m = 0; m < 4; ++m) {
    const int e = tid + 256 * m;
    const int i = e >> 4, j4 = e & 15;
    const int n = nt * 64 + j4 * 4;
    float4 v = make_float4(0.f, 0.f, 0.f, 0.f);
    if (n < Nsrc) v = *(const float4*)(src + (size_t)(kt * 64 + i) * Nsrc + n);
    tile[i * 65 + j4 * 4 + 0] = v.x; tile[i * 65 + j4 * 4 + 1] = v.y; tile[i * 65 + j4 * 4 + 2] = v.z; tile[i * 65 + j4 * 4 + 3] = v.w;
  }
  __syncthreads();
#pragma unroll
  for (int m = 0; m < 2; ++m) {
    const int e = tid + 256 * m;
    const int j = e >> 3, i8 = e & 7;
    float x[8];
#pragma unroll
    for (int kk = 0; kk < 8; ++kk) x[kk] = tile[(i8 * 8 + kk) * 65 + j];
    *(uint4*)(dst + kblk(nt * 64 + j, kt * 64 + i8 * 8, isin ? PWP : DM)) = make_uint4(pk2(x[0], x[1]), pk2(x[2], x[3]), pk2(x[4], x[5]), pk2(x[6], x[7]));
  }
}
constexpr int WT_TILES = 16 * 70 + 16 * 16;

DI void ph_prep(const Params& p, unsigned char* smem, int bid, int nb) {
  const int tid = ltid_w(p.wave);
  float* MOD = (float*)(p.ws + WS_MOD);
  float2* T32 = (float2*)(p.ws + WS_ROPE);
  float2* T64 = T32 + 64 * 8;
  const int n_mod_items = 2 * 96;
  const int total = n_mod_items + WT_TILES + 1;
  for (int it = bid; it < total; it += nb) {
    if (it >= n_mod_items && it < n_mod_items + WT_TILES) {
      wt_tile(p, 0, it - n_mod_items, smem, tid);
    } else if (it < n_mod_items) {
      const int l = it / 96, jc = it % 96;
      float* sc = (float*)smem;
      __syncthreads();
      for (int e = tid; e < 9 * 1024; e += 256) {
        const int rr = e >> 10, k = e & 1023;
        const float v = rr < 8 ? p.c[rr * 1024 + k] : p.c_ctx[k];
        sc[e] = siluf_(v);
      }
      __syncthreads();
      const int jj = tid & 31, kq = tid >> 5;
      const int j = jc * 32 + jj;
      float acc[9];
#pragma unroll
      for (int rr = 0; rr < 9; ++rr) acc[rr] = 0.f;
      const float* wm = p.w_mod + (size_t)l * DM * 3072 + j;
#pragma unroll 1
      for (int k0 = kq * 128; k0 < kq * 128 + 128; k0 += 16) {
        float w[16];
#pragma unroll
        for (int u = 0; u < 16; ++u) w[u] = wm[(size_t)(k0 + u) * 3072];
#pragma unroll
        for (int u = 0; u < 16; ++u)
#pragma unroll
          for (int rr = 0; rr < 9; ++rr) acc[rr] += sc[rr * 1024 + k0 + u] * w[u];
      }
      __syncthreads();
      float* red = (float*)smem;
#pragma unroll
      for (int rr = 0; rr < 9; ++rr) red[(kq * 9 + rr) * 32 + jj] = acc[rr];
      __syncthreads();
      for (int e = tid; e < 9 * 32; e += 256) {
        const int rr = e >> 5, j2 = e & 31;
        float s = 0.f;
#pragma unroll
        for (int q8 = 0; q8 < 8; ++q8) s += red[(q8 * 9 + rr) * 32 + j2];
        MOD[((size_t)l * 9 + rr) * 3072 + jc * 32 + j2] = s + p.b_mod[l * 3072 + jc * 32 + j2];
      }
    } else {
      for (int e = tid; e < 64 * 8; e += 256) {
        const int pos = e >> 3, i = e & 7;
        const float inv = (float)pow(10000.0, -(double)(2 * i) / 16.0);
        const double a = (double)((float)pos * inv);
        T32[e] = make_float2((float)cos(a), (float)sin(a));
      }
      for (int e = tid; e < 64 * 16; e += 256) {
        const int pos = e >> 4, i = e & 15;
        const float inv = (float)pow(10000.0, -(double)(2 * i) / 32.0);
        const double a = (double)((float)pos * inv);
        T64[e] = make_float2((float)cos(a), (float)sin(a));
      }
    }
  }
}

DI const float* xsrc_row(const Params& p, int l, int b, int t) {
  if (t < NCTX) return (l == 0 ? p.ctx : (const float*)(p.ws + WS_XRC)) + ((size_t)b * NCTX + t) * DM;
  return (l == 0 ? p.x : (const float*)p.out) + ((size_t)b * NLAT + (t - NCTX)) * DM;
}

DI void ph_norm(const Params& p, int l, int bid, int nb) {
  const int tid_ = ltid_w(p.wave); const int lane = tid_ & 63, w = tid_ >> 6;
  bf16_t* H = (bf16_t*)(p.ws + WS_HM);
  const float* MOD = (const float*)(p.ws + WS_MOD);
  const float* g = p.norm_g + l * DM;
  for (int it = bid; it < ROWS / 8; it += nb) {
    float4 v[2][4];
    const float* mod[2];
#pragma unroll
    for (int rr = 0; rr < 2; ++rr) {
      const int row = it * 8 + rr * 4 + w;
      const int b = row / NTOK, t = row % NTOK;
      const float* src = xsrc_row(p, l, b, t);
      mod[rr] = MOD + ((size_t)l * 9 + (t < NCTX ? 8 : b)) * 3072;
#pragma unroll
      for (int i = 0; i < 4; ++i) v[rr][i] = *(const float4*)(src + (i * 64 + lane) * 4);
    }
#pragma unroll
    for (int rr = 0; rr < 2; ++rr) {
      const int row = it * 8 + rr * 4 + w;
      float ss = 0.f;
#pragma unroll
      for (int i = 0; i < 4; ++i) ss += v[rr][i].x * v[rr][i].x + v[rr][i].y * v[rr][i].y + v[rr][i].z * v[rr][i].z + v[rr][i].w * v[rr][i].w;
      ss = wave_sum(ss);
      const float rstd = rsqrtf(ss * (1.f / DM) + EPS);
#pragma unroll
      for (int i = 0; i < 4; ++i) {
        const int j = (i * 64 + lane) * 4;
        const float4 gg = *(const float4*)(g + j);
        const float4 sh = *(const float4*)(mod[rr] + j);
        const float4 sc = *(const float4*)(mod[rr] + 1024 + j);
        uint2 o;
        o.x = pk2(v[rr][i].x * rstd * gg.x * (1.f + sc.x) + sh.x, v[rr][i].y * rstd * gg.y * (1.f + sc.y) + sh.y);
        o.y = pk2(v[rr][i].z * rstd * gg.z * (1.f + sc.z) + sh.z, v[rr][i].w * rstd * gg.w * (1.f + sc.w) + sh.w);
        *(uint2*)(H + kblk(row, j, ROWS)) = o;
      }
    }
  }
}

template <class Epi>
DI void gemm_simple(const bf16_t* __restrict__ A, const bf16_t* __restrict__ Bt, int M, int NT64, int K, unsigned char* smem, int bid, int nb, Epi epi) {
  float* sA = (float*)smem;
  float* sB = sA + 16 * 68;
  const int tid = threadIdx.x, tx = tid & 15, ty = tid >> 4;
  const int MT = M / 64;
  for (int it = bid; it < MT * NT64; it += nb) {
    const int mt = it / NT64, nt = it % NT64;
    float acc[4][4];
#pragma unroll
    for (int i = 0; i < 4; ++i)
#pragma unroll
      for (int j = 0; j < 4; ++j) acc[i][j] = 0.f;
    const int lr = tid >> 2, lk = (tid & 3) * 4;
    const bf16_t* ap = A + (size_t)(mt * 64 + lr) * K + lk;
    const bf16_t* bp = Bt + (size_t)(nt * 64 + lr) * K + lk;
    for (int k0 = 0; k0 < K; k0 += 16) {
      const ushort4 av = *(const ushort4*)(ap + k0);
      const ushort4 bv = *(const ushort4*)(bp + k0);
      __syncthreads();
      sA[(lk + 0) * 68 + lr] = bf2f(av.x); sA[(lk + 1) * 68 + lr] = bf2f(av.y); sA[(lk + 2) * 68 + lr] = bf2f(av.z); sA[(lk + 3) * 68 + lr] = bf2f(av.w);
      sB[(lk + 0) * 68 + lr] = bf2f(bv.x); sB[(lk + 1) * 68 + lr] = bf2f(bv.y); sB[(lk + 2) * 68 + lr] = bf2f(bv.z); sB[(lk + 3) * 68 + lr] = bf2f(bv.w);
      __syncthreads();
#pragma unroll
      for (int kk = 0; kk < 16; ++kk) {
        const float4 a4 = *(const float4*)(sA + kk * 68 + ty * 4);
        const float4 b4 = *(const float4*)(sB + kk * 68 + tx * 4);
        const float a_[4] = {a4.x, a4.y, a4.z, a4.w}, b_[4] = {b4.x, b4.y, b4.z, b4.w};
#pragma unroll
        for (int i = 0; i < 4; ++i)
#pragma unroll
          for (int j = 0; j < 4; ++j) acc[i][j] += a_[i] * b_[j];
      }
    }
#pragma unroll
    for (int i = 0; i < 4; ++i)
#pragma unroll
      for (int j = 0; j < 4; ++j) epi(mt * 64 + ty * 4 + i, nt * 64 + tx * 4 + j, acc[i][j]);
  }
}

struct EpiIn {
  bf16_t* P; float* G; const float* bias;
  DI void operator()(int row, int col, float v) const {
    if (col >= PW) return;
    v += bias[col];
    P[(size_t)row * PW + col] = f2bf(v);
    if (col >= D_G && col < D_G + 16) G[(size_t)row * 16 + (col - D_G)] = v;
  }
};
struct EpiOut {
  const Params* p; int l; const float* MOD;
  DI void operator()(int row, int col, float v) const {
    const int b = row / NTOK, t = row % NTOK;
    if (t < NCTX && l == 1) return;
    const float g = MOD[((size_t)l * 9 + (t < NCTX ? 8 : b)) * 3072 + 2048 + col];
    const float xo = xsrc_row(*p, l, b, t)[col];
    float* dst = (t < NCTX) ? (float*)(p->ws + WS_XRC) + ((size_t)b * NCTX + t) * DM : p->out + ((size_t)b * NLAT + (t - NCTX)) * DM;
    dst[col] = xo + g * v;
  }
};


using bf16x8 = __attribute__((ext_vector_type(8))) short;
using f32x16 = __attribute__((ext_vector_type(16))) float;
using f32x2 = __attribute__((ext_vector_type(2))) float;
#define MFMA32(a, b, c) __builtin_amdgcn_mfma_f32_32x32x16_bf16((a), (b), (c), 0, 0, 0)
DI int crow(int reg, int h) { return (reg & 3) + 8 * (reg >> 2) + 4 * h; }

#define RAW_BARRIER() do { asm volatile("s_waitcnt lgkmcnt(0)" ::: "memory"); __builtin_amdgcn_s_barrier(); } while (0)
template <int WM, class Epi>
DI void gemm_mfma(const bf16_t* __restrict__ A, const bf16_t* __restrict__ Bt, int Arows, int Brows, int MT, int NT, unsigned char* smem, int bid, int nb, int wave, Epi epi) {
  constexpr int K = DM;
  constexpr int BMROWS = WM * 64;
  constexpr int A_BYTES = BMROWS * 64;
  constexpr int STAGE = A_BYTES + 128 * 64;
  constexpr int NA = BMROWS / 16;
  constexpr int NI = (NA + 8) / 4;
  const int tid = ltid_w(wave), lane = tid & 63, wv = tid >> 6;
  const int wm = wv >> 1, wn = wv & 1;
  const int r = lane & 31, h = lane >> 5;
  const int lrow = lane >> 2, lpc = lane & 3;
  const unsigned lds0 = (unsigned)(size_t)smem;
  const int rowA = wm * (WM * 32) + r, rowB = wn * 64 + r;
  const unsigned offA0 = (unsigned)(rowA * 64 + (((0 + h) ^ ((rowA >> 2) & 3)) << 4)), offA1 = (unsigned)(rowA * 64 + (((2 + h) ^ ((rowA >> 2) & 3)) << 4));
  const unsigned offB0 = (unsigned)(A_BYTES + rowB * 64 + (((0 + h) ^ ((rowB >> 2) & 3)) << 4)), offB1 = (unsigned)(A_BYTES + rowB * 64 + (((2 + h) ^ ((rowB >> 2) & 3)) << 4));
  const int PN = (NT % 7 == 0) ? 35 : 8, PM = (NT % 7 == 0) ? 2 : 8, NPN = NT / PN;
  const bool xsplit = (nb % 8 == 0) && ((MT * NT) % 8 == 0);
  const int per = xsplit ? (MT * NT) / 8 : MT * NT, xq = xsplit ? bid % 8 : 0, lstep = xsplit ? nb / 8 : nb, l0 = xsplit ? bid / 8 : bid;
  for (int li = l0; li < per; li += lstep) {
    const int wi = xq * per + li;
    const int patch = wi / (PM * PN), within = wi % (PM * PN);
    const int mt = epi.mt_of((patch / NPN) * PM + within / PN), nt = (patch % NPN) * PN + within % PN;
    f32x16 acc[WM][2];
#pragma unroll
    for (int a = 0; a < WM; ++a)
#pragma unroll
      for (int b = 0; b < 2; ++b)
#pragma unroll
        for (int i = 0; i < 16; ++i) acc[a][b][i] = 0.f;
    constexpr int NAW = NA / 4;
    const int wvu = __builtin_amdgcn_readfirstlane(wv);
    const unsigned voff = (unsigned)((lrow * 32 + ((lpc ^ ((lrow >> 2) & 3)) << 3)) * 2);
    const char* abase = (const char*)(A + (size_t)(mt * BMROWS + wvu * NAW * 16) * 32);
    const char* bbase = (const char*)(Bt + (size_t)(nt * 128 + wvu * 2 * 16) * 32);
    const size_t astep = (size_t)Arows * 64, bstep = (size_t)Brows * 64;
    auto issue = [&](int kt, int buf) {
#pragma unroll
      for (int i = 0; i < NAW; ++i)
        __builtin_amdgcn_global_load_lds((const unsigned*)(abase + kt * astep + i * 1024 + voff),
                                         (__attribute__((address_space(3))) unsigned*)(smem + buf * STAGE + (wvu * NAW + i) * 1024), 16, 0, 0);
#pragma unroll
      for (int i = 0; i < 2; ++i)
        __builtin_amdgcn_global_load_lds((const unsigned*)(bbase + kt * bstep + i * 1024 + voff),
                                         (__attribute__((address_space(3))) unsigned*)(smem + buf * STAGE + A_BYTES + (wvu * 2 + i) * 1024), 16, 0, 0);
    };
    RAW_BARRIER();
    constexpr int NST = (WM == 2) ? 4 : 3;
    constexpr int NKT = K / 32;
#pragma unroll
    for (int s = 0; s < NST - 1; ++s) issue(s, s);
    bf16x8 fa0[WM], fb0[2], fa1[WM], fb1[2];
#pragma unroll
    for (int mi = 0; mi < WM; ++mi) { fa0[mi] = bf16x8{0, 0, 0, 0, 0, 0, 0, 0}; fa1[mi] = fa0[mi]; }
    fb0[0] = bf16x8{0, 0, 0, 0, 0, 0, 0, 0}; fb0[1] = fb0[0]; fb1[0] = fb0[0]; fb1[1] = fb0[0];
#define GEMM_READ4(A_, B_, FA, FB) asm volatile( \
        "ds_read_b128 %0, %6\n\tds_read_b128 %1, %6 offset:2048\n\tds_read_b128 %2, %6 offset:4096\n\tds_read_b128 %3, %6 offset:6144\n\t" \
        "ds_read_b128 %4, %7\n\tds_read_b128 %5, %7 offset:2048" \
        : "=&v"(FA[0]), "=&v"(FA[1]), "=&v"(FA[2]), "=&v"(FA[3]), "=&v"(FB[0]), "=&v"(FB[1]) : "v"(A_), "v"(B_) : "memory")
#define GEMM_READ2(A_, B_, FA, FB) asm volatile( \
        "ds_read_b128 %0, %4\n\tds_read_b128 %1, %4 offset:2048\n\tds_read_b128 %2, %5\n\tds_read_b128 %3, %5 offset:2048" \
        : "=&v"(FA[0]), "=&v"(FA[1]), "=&v"(FB[0]), "=&v"(FB[1]) : "v"(A_), "v"(B_) : "memory")
#define GEMM_WAIT4(FA, FB) asm volatile("s_waitcnt lgkmcnt(0)" : "+v"(FA[0]), "+v"(FA[1]), "+v"(FA[2]), "+v"(FA[3]), "+v"(FB[0]), "+v"(FB[1]) :: "memory")
#define GEMM_WAIT2(FA, FB) asm volatile("s_waitcnt lgkmcnt(0)" : "+v"(FA[0]), "+v"(FA[1]), "+v"(FB[0]), "+v"(FB[1]) :: "memory")
#define GEMM_MMA(FA, FB) do { __builtin_amdgcn_s_setprio(1); \
      _Pragma("unroll") for (int mi = 0; mi < WM; ++mi) _Pragma("unroll") for (int ni = 0; ni < 2; ++ni) acc[mi][ni] = MFMA32(FA[mi], FB[ni], acc[mi][ni]); \
      __builtin_amdgcn_s_setprio(0); } while (0)
#pragma unroll 1
    for (int kt = 0; kt < NKT; ++kt) {
      const int ahead = (NKT - 1 - kt < NST - 2) ? (NKT - 1 - kt) : (NST - 2);
      if (NI == 4) { if (ahead == 2) asm volatile("s_waitcnt vmcnt(8)" ::: "memory"); else if (ahead == 1) asm volatile("s_waitcnt vmcnt(4)" ::: "memory"); else asm volatile("s_waitcnt vmcnt(0)" ::: "memory"); }
      else { if (ahead == 1) asm volatile("s_waitcnt vmcnt(6)" ::: "memory"); else asm volatile("s_waitcnt vmcnt(0)" ::: "memory"); }
      RAW_BARRIER();
      if (kt + NST - 1 < NKT) issue(kt + NST - 1, (kt + NST - 1) % NST);
      const unsigned sb = lds0 + (unsigned)((kt % NST) * STAGE);
      const unsigned a0 = sb + offA0, a1 = sb + offA1, b0 = sb + offB0, b1 = sb + offB1;
      if constexpr (WM == 4) GEMM_READ4(a0, b0, fa0, fb0); else GEMM_READ2(a0, b0, fa0, fb0);
      GEMM_MMA(fa1, fb1);
      if constexpr (WM == 4) { GEMM_WAIT4(fa0, fb0); GEMM_READ4(a1, b1, fa1, fb1); } else { GEMM_WAIT2(fa0, fb0); GEMM_READ2(a1, b1, fa1, fb1); }
      GEMM_MMA(fa0, fb0);
    }
    if constexpr (WM == 4) GEMM_WAIT4(fa1, fb1); else GEMM_WAIT2(fa1, fb1);
    GEMM_MMA(fa1, fb1);
    int r2 = r, h2 = h;
    asm volatile("" : "+v"(r2), "+v"(h2));
    epi(mt, nt, wm, wn, r2, h2, acc);
  }
}

template <int WM>
struct EpiInM {
  bf16_t* P; float* G; const float* bias; const float2* T32; const float2* T64; bf16_t* VTA; bf16_t* VTC; unsigned char* smem;
  DI int mt_of(int mtv) const { return mtv; }
  DI void operator()(int mt, int nt, int wm, int wn, int r, int h, f32x16 (&acc)[WM][2]) const {
    constexpr int LD = 132;
    float* T = (float*)smem;
    const int tid = wm * 128 + wn * 64 + h * 32 + r;
#pragma unroll
    for (int ps = 0; ps < WM / 2; ++ps) {
      RAW_BARRIER();
#pragma unroll
      for (int mh = 0; mh < 2; ++mh)
#pragma unroll
        for (int ni = 0; ni < 2; ++ni)
#pragma unroll
          for (int i = 0; i < 16; ++i)
            T[(wm * 64 + mh * 32 + (i & 3) + 8 * (i >> 2) + 4 * h) * LD + wn * 64 + ni * 32 + r] = acc[ps * 2 + mh][ni][i];
      RAW_BARRIER();
      const int ropemode0 = (nt < 4) ? 1 : ((nt >= 14 && nt <= 16) ? 2 : 0);
#pragma unroll
      for (int j = 0; j < 8; ++j) {
        const int id = tid + 256 * j;
        const int lr = id >> 4, cc = id & 15;
        const int row = mt * (WM * 64) + (lr >> 6) * (WM * 32) + ps * 64 + (lr & 63);
        const int col0 = nt * 128 + cc * 8;
        if (col0 < PW) {
          const int t = row % NTOK;
          const int ropemode = (t >= NCTX) ? ropemode0 : 0;
          const float4 a0 = *(const float4*)(T + lr * LD + cc * 8), a1 = *(const float4*)(T + lr * LD + cc * 8 + 4);
          const float4 b0 = *(const float4*)(bias + col0), b1 = *(const float4*)(bias + col0 + 4);
          float v[8] = {a0.x + b0.x, a0.y + b0.y, a0.z + b0.z, a0.w + b0.w, a1.x + b1.x, a1.y + b1.y, a1.z + b1.z, a1.w + b1.w};
          if (ropemode != 0) {
            const int pc = (ropemode == 1) ? (cc ^ 1) : (cc ^ 2);
            const float4 p0 = *(const float4*)(T + lr * LD + pc * 8), p1 = *(const float4*)(T + lr * LD + pc * 8 + 4);
            const float4 c0 = *(const float4*)(bias + nt * 128 + pc * 8), c1 = *(const float4*)(bias + nt * 128 + pc * 8 + 4);
            const float pr[8] = {p0.x + c0.x, p0.y + c0.y, p0.z + c0.z, p0.w + c0.w, p1.x + c1.x, p1.y + c1.y, p1.z + c1.z, p1.w + c1.w};
            const int tok = t - NCTX;
            const int q = (ropemode == 1) ? (cc & 3) : ((cc & 7) >> 1);
            const int pos = (q < 2) ? (tok >> 6) : (tok & 63);
            const float2* tab = (ropemode == 1) ? (T32 + pos * 8) : (T64 + pos * 16 + (cc & 1) * 8);
            const float sgn = (q & 1) ? 1.f : -1.f;
#pragma unroll
            for (int k = 0; k < 8; ++k) { const float2 cs = tab[k]; v[k] = v[k] * cs.x + sgn * pr[k] * cs.y; }
          }
          *(uint4*)(P + (size_t)row * PW + col0) = make_uint4(pk2(v[0], v[1]), pk2(v[2], v[3]), pk2(v[4], v[5]), pk2(v[6], v[7]));
          if (nt == 24 && cc < 2) {
            *(float4*)(G + (size_t)row * 16 + cc * 8) = make_float4(v[0], v[1], v[2], v[3]);
            *(float4*)(G + (size_t)row * 16 + cc * 8 + 4) = make_float4(v[4], v[5], v[6], v[7]);
          }
        }
      }
      if (nt == 4 || nt == 5 || nt == 17) {
#pragma unroll
        for (int j = 0; j < 8; ++j) {
          const int id = tid + 256 * j;
          const int c = id & 127, rg = id >> 7;
          const int lr0 = rg * 8;
          const int row = mt * (WM * 64) + (lr0 >> 6) * (WM * 32) + ps * 64 + (lr0 & 63);
          const int b = row / NTOK, t = row % NTOK;
          const int col = nt * 128 + c;
          const float bb = bias[col];
          float x[8];
#pragma unroll
          for (int k = 0; k < 8; ++k) x[k] = T[(lr0 + k) * LD + c] + bb;
          bf16_t* vt = (nt == 17) ? VTC + ((size_t)b * 128 + (col - C_V)) * NTOK : VTA + ((size_t)b * 256 + (col - A_V)) * NTOK;
          *(uint4*)(vt + t) = make_uint4(pk2(x[0], x[1]), pk2(x[2], x[3]), pk2(x[4], x[5]), pk2(x[6], x[7]));
        }
      }
    }
  }
};
template <int WM>
struct EpiNull {
  float* sink;
  DI int mt_of(int mtv) const { return mtv; }
  DI void operator()(int mt, int nt, int wm, int wn, int r, int h, f32x16 (&acc)[WM][2]) const {
    float s = 0.f;
#pragma unroll
    for (int a = 0; a < WM; ++a)
#pragma unroll
      for (int b = 0; b < 2; ++b)
#pragma unroll
        for (int i = 0; i < 16; ++i) s += acc[a][b][i];
    if (s == 1.2345e30f) sink[0] = s;
  }
};
template <int WM>
struct EpiOutM {
  const Params* p; int l; const float* MOD; unsigned char* smem; int mode;
  DI int mt_of(int mtv) const { return mode == 1 ? (WM == 4 ? (mtv >> 3) * 9 + 1 + (mtv & 7) : (mtv >> 4) * 18 + 2 + (mtv & 15)) : (WM == 4 ? mtv * 9 : (mtv >> 1) * 18 + (mtv & 1)); }
  DI void operator()(int mt, int nt, int wm, int wn, int r, int h, f32x16 (&acc)[WM][2]) const {
    constexpr int LD = 132;
    float* T = (float*)smem;
    const int tid = wm * 128 + wn * 64 + h * 32 + r;
#pragma unroll
    for (int ps = 0; ps < WM / 2; ++ps) {
      RAW_BARRIER();
#pragma unroll
      for (int mh = 0; mh < 2; ++mh)
#pragma unroll
        for (int ni = 0; ni < 2; ++ni)
#pragma unroll
          for (int i = 0; i < 16; ++i)
            T[(wm * 64 + mh * 32 + (i & 3) + 8 * (i >> 2) + 4 * h) * LD + wn * 64 + ni * 32 + r] = acc[ps * 2 + mh][ni][i];
      RAW_BARRIER();
#pragma unroll 4
      for (int j = 0; j < 16; ++j) {
        const int id = tid + 256 * j;
        const int lr = id >> 5, cc = id & 31;
        const int row = mt * (WM * 64) + (lr >> 6) * (WM * 32) + ps * 64 + (lr & 63);
        const int b = row / NTOK, t = row % NTOK;
        const bool isctx = t < NCTX;
        if (isctx && l == 1) continue;
        const int col = nt * 128 + cc * 4;
        const float4 a = *(const float4*)(T + lr * LD + cc * 4);
        const float4 g = *(const float4*)(MOD + ((size_t)l * 9 + (isctx ? 8 : b)) * 3072 + 2048 + col);
        const float4 xo = *(const float4*)(xsrc_row(*p, l, b, t) + col);
        float* dst = (isctx ? (float*)(p->ws + WS_XRC) + ((size_t)b * NCTX + t) * DM : p->out + ((size_t)b * NLAT + (t - NCTX)) * DM) + col;
        *(float4*)dst = make_float4(xo.x + g.x * a.x, xo.y + g.y * a.y, xo.z + g.z * a.z, xo.w + g.w * a.w);
      }
    }
  }
};

DI void ph_rope(const Params& p, int bid, int nb) {
  bf16_t* P = (bf16_t*)(p.ws + WS_P);
  const float2* T32 = (const float2*)(p.ws + WS_ROPE);
  const float2* T64 = T32 + 64 * 8;
  const int total = NB * NLAT * 448;
  for (int e = bid * 256 + threadIdx.x; e < total; e += nb * 256) {
    const int tokg = e / 448, pr = e % 448;
    const int b = tokg / NLAT, tok = tokg % NLAT;
    bf16_t* rowp = P + ((size_t)b * NTOK + NCTX + tok) * PW;
    int c1, c2; float2 cs;
    if (pr < 256) {
      const int g = pr >> 4, pi = pr & 15;
      if (pi < 8) { c1 = g * 32 + pi; c2 = c1 + 8; cs = T32[(tok >> 6) * 8 + pi]; }
      else { const int i = pi - 8; c1 = g * 32 + 16 + i; c2 = c1 + 8; cs = T32[(tok & 63) * 8 + i]; }
    } else {
      const int q = pr - 256; const int g = q >> 5, pi = q & 31;
      if (pi < 16) { c1 = C_Q + g * 64 + pi; c2 = c1 + 16; cs = T64[(tok >> 6) * 16 + pi]; }
      else { const int i = pi - 16; c1 = C_Q + g * 64 + 32 + i; c2 = c1 + 16; cs = T64[(tok & 63) * 16 + i]; }
    }
    const float x1 = bf2f(rowp[c1]), x2 = bf2f(rowp[c2]);
    rowp[c1] = f2bf(x1 * cs.x - x2 * cs.y);
    rowp[c2] = f2bf(x2 * cs.x + x1 * cs.y);
  }
}

DI int seq_tok(int dir, int pos) { return dir == 0 ? pos : (pos < NCTX ? NCTX - 1 - pos : 2559 - pos); }

DI void hgrn_scan(const Params& p, int l, int b, int h, int dir, unsigned char* smem) {
  const int tid = ltid_w(p.wave), lane = tid & 63, w = tid >> 6;
  bf16_t* P = (bf16_t*)(p.ws + WS_P);
  float* sf = (float*)smem;
  float* sk = sf + 1024;
  float* sq = sk + 1024;
  float* si = sq + 1024;
  float* sp = si + 1024;
  const int fcol = (dir ? B_FB : B_FF) + h * 64;
  float S[16];
#pragma unroll
  for (int i = 0; i < 16; ++i) S[i] = 0.f;
  for (int c = 0; c < NTOK / 16; ++c) {
    __syncthreads();
    for (int e = tid; e < 1024; e += 256) {
      const int tt = e >> 6, k = e & 63;
      const int t = seq_tok(dir, c * 16 + tt);
      const bf16_t* rp = P + ((size_t)b * NTOK + t) * PW;
      float lb = 0.f;
      if (l == 1) lb = sigmoidf_(p.hg_lb[256 + h * 64 + k] - p.hg_lb[h * 64 + k]);
      const float z = bf2f(rp[fcol + k]);
      const float sg = sigmoidf_(z);
      sf[e] = lb + (1.f - lb) * sg;
      sk[e] = (1.f - lb) * (1.f - sg);
      sq[e] = bf2f(rp[B_Q + h * 64 + k]) * 0.125f;
      si[e] = bf2f(rp[B_I + h * 64 + k]);
    }
    __syncthreads();
    for (int tt = 0; tt < 16; ++tt) {
      const float iv = si[tt * 64 + lane];
      float o = 0.f;
#pragma unroll
      for (int kk = 0; kk < 16; ++kk) {
        const int k = w * 16 + kk;
        S[kk] = sf[tt * 64 + k] * S[kk] + sk[tt * 64 + k] * iv;
        o += sq[tt * 64 + k] * S[kk];
      }
      sp[(w * 16 + tt) * 64 + lane] = o;
    }
    __syncthreads();
    for (int e = tid; e < 1024; e += 256) {
      const int tt = e >> 6, v = e & 63;
      const int t = seq_tok(dir, c * 16 + tt);
      const float o = sp[(0 * 16 + tt) * 64 + v] + sp[(1 * 16 + tt) * 64 + v] + sp[(2 * 16 + tt) * 64 + v] + sp[(3 * 16 + tt) * 64 + v];
      P[((size_t)b * NTOK + t) * PW + fcol + v] = f2bf(o);
    }
  }
}

DI void attnA_naive(const Params& p, int l, int b, int h, int qb, unsigned char* smem) {
  const int tid = ltid_w(p.wave);
  const bf16_t* P = (const bf16_t*)(p.ws + WS_P);
  bf16_t* MIX = (bf16_t*)(p.ws + WS_HM);
  float* sk = (float*)smem;
  float* sv = sk + 2048;
  float* so = sv + 2048;
  const int mp = tid >> 7;
  const int t = qb * 128 + (tid & 127);
  const size_t row = (size_t)b * NTOK + t;
  const float lam_init = 0.8f - 0.6f * __expf(-0.3f * (float)l);
  float s01 = 0.f, s23 = 0.f;
  for (int i = 0; i < 32; ++i) {
    s01 += p.diff_lam[l * 128 + i] * p.diff_lam[l * 128 + 32 + i];
    s23 += p.diff_lam[l * 128 + 64 + i] * p.diff_lam[l * 128 + 96 + i];
  }
  const float lam = expf(s01) - expf(s23) + lam_init;
  const float scale = 0.17677669529663687f;
  float q[32], o0[64];
#pragma unroll
  for (int d = 0; d < 32; ++d) q[d] = bf2f(P[row * PW + A_Q + h * 64 + mp * 32 + d]) * scale;
#pragma unroll
  for (int d = 0; d < 64; ++d) o0[d] = 0.f;
  float m0 = -1e30f, l0 = 0.f;
  const int nkeys = (qb < 2) ? NCTX : NTOK;
  for (int k0 = 0; k0 < nkeys; k0 += 32) {
    __syncthreads();
    for (int e = tid; e < 2048; e += 256) {
      const int kk = e >> 6, d = e & 63;
      const bf16_t* rp = P + ((size_t)b * NTOK + k0 + kk) * PW;
      sk[e] = bf2f(rp[A_K + h * 64 + d]);
      sv[e] = bf2f(rp[A_V + h * 64 + d]);
    }
    __syncthreads();
    for (int kk = 0; kk < 32; ++kk) {
      float s0 = 0.f;
#pragma unroll
      for (int d = 0; d < 32; ++d) s0 += q[d] * sk[kk * 64 + mp * 32 + d];
      if (s0 > m0) { const float a = __expf(m0 - s0); l0 *= a;
#pragma unroll
        for (int d = 0; d < 64; ++d) o0[d] *= a;
        m0 = s0; }
      const float p0 = __expf(s0 - m0);
      l0 += p0;
#pragma unroll
      for (int d = 0; d < 64; ++d) o0[d] += p0 * sv[kk * 64 + d];
    }
  }
  const float i0 = (mp ? lam : 1.f) / l0;
  if (mp) {
#pragma unroll
    for (int d = 0; d < 64; ++d) so[(tid & 127) * 65 + d] = o0[d] * i0;
  }
  __syncthreads();
  if (!mp) {
    float ss = 0.f;
#pragma unroll
    for (int d = 0; d < 64; ++d) { o0[d] = o0[d] * i0 - so[tid * 65 + d]; ss += o0[d] * o0[d]; }
    const float rstd = rsqrtf(ss * (1.f / 64.f) + EPS) * (1.f - lam_init);
#pragma unroll
    for (int d = 0; d < 64; ++d) {
      const float gt = siluf_(bf2f(P[row * PW + GATE + h * 64 + d]));
      MIX[row * DM + h * 64 + d] = f2bf(o0[d] * rstd * p.diff_g[l * 64 + d] * gt);
    }
  }
}

DI void attnC_naive(const Params& p, int l, int b, int hq, int qb, unsigned char* smem) {
  const int tid = ltid_w(p.wave);
  const bf16_t* P = (const bf16_t*)(p.ws + WS_P);
  bf16_t* MIX = (bf16_t*)(p.ws + WS_HM);
  float* sk = (float*)smem;
  float* sv = sk + 2048;
  const int kvh = hq >> 1;
  const int t = qb * 256 + tid;
  const size_t row = (size_t)b * NTOK + t;
  float q[64], o[64];
#pragma unroll
  for (int d = 0; d < 64; ++d) { q[d] = bf2f(P[row * PW + C_Q + hq * 64 + d]) * 0.125f; o[d] = 0.f; }
  float m = p.sw_sink[l * 4 + hq], lsum = 1.f;
  const int i = t - NCTX;
  int jlo = 0, jhi = 0;
  if (qb > 0) { jlo = (qb - 1) * 256 - 128; if (jlo < 0) jlo = 0; jhi = (qb - 1) * 256 + 256 + 128; if (jhi > NLAT) jhi = NLAT; }
  const int ntiles = 8 + (jhi - jlo) / 32;
  for (int tl = 0; tl < ntiles; ++tl) {
    const int kt0 = tl < 8 ? tl * 32 : NCTX + jlo + (tl - 8) * 32;
    __syncthreads();
    for (int e = tid; e < 2048; e += 256) {
      const int kk = e >> 6, d = e & 63;
      const bf16_t* rp = P + ((size_t)b * NTOK + kt0 + kk) * PW;
      sk[e] = bf2f(rp[C_K + kvh * 64 + d]);
      sv[e] = bf2f(rp[C_V + kvh * 64 + d]);
    }
    __syncthreads();
    for (int kk = 0; kk < 32; ++kk) {
      if (tl >= 8) { const int j = kt0 + kk - NCTX; const int dd = i - j; if (dd > 128 || dd < -128) continue; }
      float s = 0.f;
#pragma unroll
      for (int d = 0; d < 64; ++d) s += q[d] * sk[kk * 64 + d];
      if (s > m) { const float a = __expf(m - s); lsum *= a;
#pragma unroll
        for (int d = 0; d < 64; ++d) o[d] *= a;
        m = s; }
      const float pp = __expf(s - m);
      lsum += pp;
#pragma unroll
      for (int d = 0; d < 64; ++d) o[d] += pp * sv[kk * 64 + d];
    }
  }
  const float inv = 1.f / lsum;
#pragma unroll
  for (int d = 0; d < 64; ++d) {
    const float gt = siluf_(bf2f(P[row * PW + GATE + 512 + hq * 64 + d]));
    MIX[row * DM + 512 + hq * 64 + d] = f2bf(o[d] * inv * gt);
  }
}


DI bf16x8 pack8(const f32x16& x, int s) {
  const uint4 u = make_uint4(pk2(x[8 * s + 0], x[8 * s + 1]), pk2(x[8 * s + 2], x[8 * s + 3]), pk2(x[8 * s + 4], x[8 * s + 5]), pk2(x[8 * s + 6], x[8 * s + 7]));
  return __builtin_bit_cast(bf16x8, u);
}
template <int MODE>
DI void attn_mfma(const Params& p, int l, int b, int hd, int qb, unsigned char* smem) {
  constexpr int KS = MODE ? 4 : 2;
  constexpr int QPB = MODE ? 128 : 64;
  const int tid = ltid_w(p.wave), lane = tid & 63, wv = tid >> 6, r = lane & 31, h2 = lane >> 5;
  const int mp = MODE ? 0 : (wv >> 1);
  const bf16_t* P = (const bf16_t*)(p.ws + WS_P);
  bf16_t* MIX = (bf16_t*)(p.ws + WS_HM);
  const int kvh = MODE ? (hd >> 1) : hd;
  const bf16_t* VT = MODE ? (const bf16_t*)(p.ws + WS_VTC) + ((size_t)(b * 2 + kvh) * 64) * NTOK : (const bf16_t*)(p.ws + WS_VTA) + ((size_t)(b * 4 + hd) * 64) * NTOK;
  const int qcol = MODE ? C_Q + hd * 64 : A_Q + hd * 64;
  const int kcol = MODE ? C_K + kvh * 64 : A_K + hd * 64;
  unsigned char* sK = smem;
  unsigned char* sV = smem + 8192;
  const int tq = qb * QPB + (MODE ? wv : (wv & 1)) * 32 + r;
  const size_t qrow = (size_t)b * NTOK + tq;
  bf16x8 qf[KS];
#pragma unroll
  for (int ks = 0; ks < KS; ++ks) qf[ks] = *(const bf16x8*)(P + qrow * PW + qcol + (2 * (mp * 2 + ks) + h2) * 8);
  const bool isctx = qb * QPB < NCTX;
  int ntiles, band_lo = 0;
  if (MODE == 0) ntiles = isctx ? 4 : 36;
  else {
    if (isctx) ntiles = 4;
    else { const int i0 = qb * QPB - NCTX; int lo = i0 - 128; if (lo < 0) lo = 0; int hi = i0 + 256; if (hi > NLAT) hi = NLAT; band_lo = lo; ntiles = 4 + (hi - lo) / 64; }
  }
  const float cexp = (MODE ? 0.125f : 0.17677669529663687f) * 1.4426950408889634f;
  float mrun = MODE ? p.sw_sink[l * 4 + hd] * 1.4426950408889634f : -1e30f;
  float lsum = (MODE && h2 == 0) ? 1.f : 0.f;
  f32x16 O[2];
#pragma unroll
  for (int vt = 0; vt < 2; ++vt)
#pragma unroll
    for (int i = 0; i < 16; ++i) O[vt][i] = 0.f;
  const int lrow = tid >> 3, lc = tid & 7;
  auto tile_base = [&](int j) -> int { return (MODE == 0 || j < 4) ? j * 64 : NCTX + band_lo + (j - 4) * 64; };
  uint4 gk00, gk01, gk10, gk11, gv00, gv01, gv10, gv11;
#define ATT_LOAD(tb_, k0_, k1_, v0_, v1_) do { const int tb__ = (tb_); \
    k0_ = *(const uint4*)(P + ((size_t)b * NTOK + tb__ + lrow) * PW + kcol + lc * 8); \
    k1_ = *(const uint4*)(P + ((size_t)b * NTOK + tb__ + lrow + 32) * PW + kcol + lc * 8); \
    v0_ = *(const uint4*)(VT + (size_t)lrow * NTOK + tb__ + lc * 8); \
    v1_ = *(const uint4*)(VT + (size_t)(lrow + 32) * NTOK + tb__ + lc * 8); } while (0)
#define ATT_STORE(hf_, k0_, k1_, v0_, v1_) do { unsigned char* sKh = sK + (hf_) * 16896; unsigned char* sVh = sV + (hf_) * 16896; \
    const int off = lrow * 128 + ((lc ^ ((lrow >> 1) & 7)) << 4); \
    *(uint4*)(sKh + off) = k0_; *(uint4*)(sKh + off + 4096) = k1_; \
    *(uint2*)(sVh + lrow * 136 + lc * 16) = make_uint2(v0_.x, v0_.y); *(uint2*)(sVh + lrow * 136 + lc * 16 + 8) = make_uint2(v0_.z, v0_.w); \
    *(uint2*)(sVh + (lrow + 32) * 136 + lc * 16) = make_uint2(v1_.x, v1_.y); *(uint2*)(sVh + (lrow + 32) * 136 + lc * 16 + 8) = make_uint2(v1_.z, v1_.w); } while (0)
  ATT_LOAD(tile_base(0), gk00, gk01, gv00, gv01);
  ATT_LOAD(tile_base(1), gk10, gk11, gv10, gv11);
  for (int j = 0; j < ntiles; j += 2) {
    __syncthreads();
    ATT_STORE(0, gk00, gk01, gv00, gv01);
    ATT_STORE(1, gk10, gk11, gv10, gv11);
    __syncthreads();
    if (j + 2 < ntiles) {
      ATT_LOAD(tile_base(j + 2), gk00, gk01, gv00, gv01);
      ATT_LOAD(tile_base(j + 3), gk10, gk11, gv10, gv11);
    }
    f32x16 SA0, SA1, SB0, SB1;
#pragma unroll
    for (int i = 0; i < 16; ++i) { SA0[i] = 0.f; SA1[i] = 0.f; SB0[i] = 0.f; SB1[i] = 0.f; }
#pragma unroll
    for (int ks = 0; ks < KS; ++ks) {
      const int kk = mp * 2 + ks;
      const int key0 = r, key1 = 32 + r;
      const int o0 = key0 * 128 + (((2 * kk + h2) ^ ((key0 >> 1) & 7)) << 4), o1 = key1 * 128 + (((2 * kk + h2) ^ ((key1 >> 1) & 7)) << 4);
      SA0 = MFMA32(*(const bf16x8*)(sK + o0), qf[ks], SA0);
      SA1 = MFMA32(*(const bf16x8*)(sK + o1), qf[ks], SA1);
      SB0 = MFMA32(*(const bf16x8*)(sK + 16896 + o0), qf[ks], SB0);
      SB1 = MFMA32(*(const bf16x8*)(sK + 16896 + o1), qf[ks], SB1);
    }
#pragma unroll
    for (int hf = 0; hf < 2; ++hf) {
    const unsigned char* sVc = sV + hf * 16896;
    const int tbcur = tile_base(j + hf);
    if (MODE == 1 && j + hf >= 4) {
      const int iw0 = qb * QPB + wv * 32 - NCTX, jb0 = tbcur - NCTX;
      if (jb0 > iw0 + 31 + 128 || jb0 + 63 < iw0 - 128) continue;
    }
    f32x16 S[2];
    S[0] = hf == 0 ? SA0 : SB0;
    S[1] = hf == 0 ? SA1 : SB1;
    if (MODE == 1 && j + hf >= 4) {
      const int iq = tq - NCTX;
      const int jb = tbcur - NCTX;
#pragma unroll
      for (int mt = 0; mt < 2; ++mt)
#pragma unroll
        for (int i = 0; i < 16; ++i) {
          const int dd = iq - (jb + mt * 32 + crow(i, h2));
          if (dd > 128 || dd < -128) S[mt][i] = -1e30f;
        }
    }
    float mx = -1e30f;
#pragma unroll
    for (int mt = 0; mt < 2; ++mt)
#pragma unroll
      for (int i = 0; i < 16; ++i) mx = fmaxf(mx, S[mt][i]);
    mx = fmaxf(mx, __shfl_xor(mx, 32));
    const float zmx = mx * cexp;
    if (__any(zmx > mrun + 8.f)) {
      const float mnew = fmaxf(mrun, zmx);
      const float alpha = __builtin_amdgcn_exp2f(mrun - mnew);
      mrun = mnew;
      lsum *= alpha;
      const f32x2 al2 = {alpha, alpha};
#pragma unroll
      for (int vt = 0; vt < 2; ++vt)
#pragma unroll
        for (int i = 0; i < 8; ++i) {
          f32x2 o = {O[vt][2 * i], O[vt][2 * i + 1]};
          o = o * al2;
          O[vt][2 * i] = o.x; O[vt][2 * i + 1] = o.y;
        }
    }
    const f32x2 c2 = {cexp, cexp}, m2 = {mrun, mrun};
    f32x2 ps2 = {0.f, 0.f};
    unsigned pk[2][8];
#pragma unroll
    for (int mt = 0; mt < 2; ++mt)
#pragma unroll
      for (int i = 0; i < 8; ++i) {
        f32x2 z = {S[mt][2 * i], S[mt][2 * i + 1]};
        z = z * c2 - m2;
        f32x2 pv = {__builtin_amdgcn_exp2f(z.x), __builtin_amdgcn_exp2f(z.y)};
        ps2 = ps2 + pv;
        pk[mt][i] = pk2(pv.x, pv.y);
      }
    lsum += ps2.x + ps2.y;
#pragma unroll
    for (int mt = 0; mt < 2; ++mt)
#pragma unroll
      for (int s = 0; s < 2; ++s) {
        const uint4 pu = make_uint4(pk[mt][4 * s], pk[mt][4 * s + 1], pk[mt][4 * s + 2], pk[mt][4 * s + 3]);
        const bf16x8 pf = __builtin_bit_cast(bf16x8, pu);
#pragma unroll
        for (int vt = 0; vt < 2; ++vt) {
          const unsigned char* bp = sVc + (vt * 32 + r) * 136 + (mt * 32 + 16 * s + 4 * h2) * 2;
          const uint2 lo = *(const uint2*)(bp);
          const uint2 hi = *(const uint2*)(bp + 16);
          const uint4 u = make_uint4(lo.x, lo.y, hi.x, hi.y);
          O[vt] = MFMA32(__builtin_bit_cast(bf16x8, u), pf, O[vt]);
        }
      }
    }
  }
  const float ltot = lsum + __shfl_xor(lsum, 32);
  if (MODE == 0) {
    const float lam_init = 0.8f - 0.6f * __expf(-0.3f * (float)l);
    float s01 = 0.f, s23 = 0.f;
    for (int i = 0; i < 32; ++i) {
      s01 += p.diff_lam[l * 128 + i] * p.diff_lam[l * 128 + 32 + i];
      s23 += p.diff_lam[l * 128 + 64 + i] * p.diff_lam[l * 128 + 96 + i];
    }
    const float lam = expf(s01) - expf(s23) + lam_init;
    float* sO = (float*)smem;
    const int ql = (wv & 1) * 32 + r;
    __syncthreads();
    if (mp == 1) {
      const float i1 = lam / ltot;
#pragma unroll
      for (int vt = 0; vt < 2; ++vt)
#pragma unroll
        for (int i = 0; i < 16; ++i) sO[ql * 65 + vt * 32 + crow(i, h2)] = O[vt][i] * i1;
    }
    __syncthreads();
    if (mp == 0) {
      const float i0 = 1.f / ltot;
      float ss = 0.f;
#pragma unroll
      for (int vt = 0; vt < 2; ++vt)
#pragma unroll
        for (int i = 0; i < 16; ++i) { const float o = O[vt][i] * i0 - sO[ql * 65 + vt * 32 + crow(i, h2)]; O[vt][i] = o; ss += o * o; }
      ss += __shfl_xor(ss, 32);
      const float rstd = rsqrtf(ss * (1.f / 64.f) + EPS) * (1.f - lam_init);
#pragma unroll
      for (int vt = 0; vt < 2; ++vt)
#pragma unroll
        for (int g4 = 0; g4 < 4; ++g4) {
          const int v0 = vt * 32 + 8 * g4 + 4 * h2;
          const ushort4 gt = *(const ushort4*)(P + qrow * PW + GATE + hd * 64 + v0);
          const float4 gg = *(const float4*)(p.diff_g + l * 64 + v0);
          uint2 o;
          o.x = pk2(O[vt][4 * g4 + 0] * rstd * gg.x * siluf_(bf2f(gt.x)), O[vt][4 * g4 + 1] * rstd * gg.y * siluf_(bf2f(gt.y)));
          o.y = pk2(O[vt][4 * g4 + 2] * rstd * gg.z * siluf_(bf2f(gt.z)), O[vt][4 * g4 + 3] * rstd * gg.w * siluf_(bf2f(gt.w)));
          *(uint2*)(MIX + kblk((int)qrow, hd * 64 + v0, ROWS)) = o;
        }
    }
  } else {
    const float i0 = 1.f / ltot;
#pragma unroll
    for (int vt = 0; vt < 2; ++vt)
#pragma unroll
      for (int g4 = 0; g4 < 4; ++g4) {
        const int v0 = vt * 32 + 8 * g4 + 4 * h2;
        const ushort4 gt = *(const ushort4*)(P + qrow * PW + GATE + 512 + hd * 64 + v0);
        uint2 o;
        o.x = pk2(O[vt][4 * g4 + 0] * i0 * siluf_(bf2f(gt.x)), O[vt][4 * g4 + 1] * i0 * siluf_(bf2f(gt.y)));
        o.y = pk2(O[vt][4 * g4 + 2] * i0 * siluf_(bf2f(gt.z)), O[vt][4 * g4 + 3] * i0 * siluf_(bf2f(gt.w)));
        *(uint2*)(MIX + kblk((int)qrow, 512 + hd * 64 + v0, ROWS)) = o;
      }
  }
}


using f32x4 = __attribute__((ext_vector_type(4))) float;
#define MFMA16(a, b, c) __builtin_amdgcn_mfma_f32_16x16x32_bf16((a), (b), (c), 0, 0, 0)
DI int swz(int row, int c) { return row * 128 + ((c ^ ((row >> 1) & 7)) << 4); }
DI float exps(float x) { return __builtin_amdgcn_exp2f(fminf(x, 115.f)); }
constexpr int L_CUM = 0, L_QM = 16384, L_KM = 24576, L_QS = 32768, L_KET = 40960, L_VT = 49152, L_STT = 57344, L_DEC = 65536, L_N0 = 65792, L_TOT = 66048, L_LB = 67072;

DI unsigned char* summ_ptr(const Params& p, int mx, int b, int h, int dir, int sc) {
  return p.ws + WS_SUMM + ((size_t)((((mx * NB + b) * 4 + h) * 2 + dir) * 9 + sc)) * SUMM_STRIDE;
}

struct RecRaw { uint4 a0, a1, b0, b1, c0, c1; float ig, fg; };
template <int MX>
DI RecRaw rec_load(const Params& p, int b, int h, int dir, int T0, int tid) {
  const bf16_t* P = (const bf16_t*)(p.ws + WS_P);
  const int tt = tid >> 2, k0 = (tid & 3) * 16;
  const size_t row = (size_t)b * NTOK + T0 + tt;
  const bf16_t* rp = P + row * PW;
  RecRaw w;
  if (MX == 0) {
    const int fcol = (dir ? B_FB : B_FF) + h * 64 + k0;
    w.a0 = *(const uint4*)(rp + fcol); w.a1 = *(const uint4*)(rp + fcol + 8);
    w.b0 = *(const uint4*)(rp + B_Q + h * 64 + k0); w.b1 = *(const uint4*)(rp + B_Q + h * 64 + k0 + 8);
    w.c0 = *(const uint4*)(rp + B_I + h * 64 + k0); w.c1 = *(const uint4*)(rp + B_I + h * 64 + k0 + 8);
    w.ig = 0.f; w.fg = 0.f;
  } else {
    w.a0 = *(const uint4*)(rp + D_K + h * 64 + k0); w.a1 = *(const uint4*)(rp + D_K + h * 64 + k0 + 8);
    w.b0 = *(const uint4*)(rp + D_Q + h * 64 + k0); w.b1 = *(const uint4*)(rp + D_Q + h * 64 + k0 + 8);
    w.c0 = *(const uint4*)(rp + D_V + h * 64 + k0); w.c1 = *(const uint4*)(rp + D_V + h * 64 + k0 + 8);
    const float* G = (const float*)(p.ws + WS_GATES) + row * 16;
    w.ig = G[dir * 4 + h]; w.fg = G[8 + dir * 4 + h];
  }
  return w;
}
template <int MX, bool OUT>
DI void rec_chunk(const Params& p, int l, int b, int h, int dir, int T0, unsigned char* smem, f32x4 (&St)[4], float& nst, float& dtot, int tid, const RecRaw& raw) {
  const int lane = tid & 63, w = tid >> 6, col = lane & 15, g = lane >> 4;
  const bf16_t* P = (const bf16_t*)(p.ws + WS_P);
  float* CUM = (float*)(smem + L_CUM);
  float* DEC = (float*)(smem + L_DEC);
  float* N0 = (float*)(smem + L_N0);
  float* TOT = (float*)(smem + L_TOT);
  const float* LB = (const float*)(smem + L_LB);
  const int tt = tid >> 2, grp = tid & 3, k0 = grp * 16;
  float qv[16], kin[16], vv[16];
  {
    const uint4 a0 = raw.a0, a1 = raw.a1, b0 = raw.b0, b1 = raw.b1, c0 = raw.c0, c1 = raw.c1;
    const unsigned au[8] = {a0.x, a0.y, a0.z, a0.w, a1.x, a1.y, a1.z, a1.w};
    const unsigned bu[8] = {b0.x, b0.y, b0.z, b0.w, b1.x, b1.y, b1.z, b1.w};
    const unsigned cu[8] = {c0.x, c0.y, c0.z, c0.w, c1.x, c1.y, c1.z, c1.w};
    float lf[16];
    if (MX == 0) {
#pragma unroll
      for (int i = 0; i < 8; ++i) {
#pragma unroll
        for (int hh = 0; hh < 2; ++hh) {
          const int k = 2 * i + hh;
          float z = __uint_as_float(hh ? (au[i] & 0xffff0000u) : (au[i] << 16));
          z = fminf(fmaxf(z, -30.f), 30.f);
          const float e = __expf(-z);
          const float sg = 1.f / (1.f + e);
          const float lb = LB[k0 + k];
          lf[k] = __log2f(lb + (1.f - lb) * sg);
          kin[k] = (1.f - lb) * (e * sg);
          qv[k] = __uint_as_float(hh ? (bu[i] & 0xffff0000u) : (bu[i] << 16)) * 0.125f;
          vv[k] = __uint_as_float(hh ? (cu[i] & 0xffff0000u) : (cu[i] << 16));
        }
      }
    } else {
      const float ig = raw.ig, fg = raw.fg;
      const float lfs = (fg < -20.f) ? fg * 1.4426950408889634f : -__log2f(1.f + __expf(-fg));
      const float ei = __expf(ig) * 0.125f;
#pragma unroll
      for (int i = 0; i < 8; ++i) {
#pragma unroll
        for (int hh = 0; hh < 2; ++hh) {
          const int k = 2 * i + hh;
          lf[k] = lfs;
          kin[k] = __uint_as_float(hh ? (au[i] & 0xffff0000u) : (au[i] << 16)) * ei;
          qv[k] = __uint_as_float(hh ? (bu[i] & 0xffff0000u) : (bu[i] << 16));
          vv[k] = __uint_as_float(hh ? (cu[i] & 0xffff0000u) : (cu[i] << 16));
        }
      }
    }
#pragma unroll
    for (int i = 0; i < 4; ++i) { if (MX == 0) *(float4*)(CUM + tt * 64 + k0 + 4 * i) = make_float4(lf[4 * i], lf[4 * i + 1], lf[4 * i + 2], lf[4 * i + 3]); }
    if (MX == 1 && grp == 0) CUM[tt * 64] = lf[0];
  }
  __syncthreads();
  if (MX == 1) {
    if (w == 0) {
      float x = CUM[lane * 64];
#pragma unroll
      for (int o = 1; o < 64; o <<= 1) {
        const float y = dir == 0 ? __shfl_up(x, o) : __shfl_down(x, o);
        const bool ok = dir == 0 ? (lane >= o) : (lane + o < 64);
        x += ok ? y : 0.f;
      }
      CUM[lane * 64] = x;
    }
    __syncthreads();
  } else {
    const int k = tid & 63, part = tid >> 6;
    float x[16];
    float acc = 0.f;
    if (dir == 0) {
#pragma unroll
      for (int i = 0; i < 16; ++i) { acc += CUM[(part * 16 + i) * 64 + k]; x[i] = acc; }
    } else {
#pragma unroll
      for (int i = 15; i >= 0; --i) { acc += CUM[(part * 16 + i) * 64 + k]; x[i] = acc; }
    }
    TOT[part * 64 + k] = acc;
    __syncthreads();
    float off = 0.f;
#pragma unroll
    for (int pp = 0; pp < 4; ++pp) { const bool take = dir == 0 ? (pp < part) : (pp > part); off += take ? TOT[pp * 64 + k] : 0.f; }
#pragma unroll
    for (int i = 0; i < 16; ++i) CUM[(part * 16 + i) * 64 + k] = x[i] + off;
  }
  __syncthreads();
  {
    const int mid = dir == 0 ? 31 : 32, last = dir == 0 ? 63 : 0;
    const int kvbase = k0 * 128 + (tt & 7) * 2, t3 = tt >> 3;
    float s_qm = 0.f, s_km = 0.f, s_qs = 0.f, s_ke = 0.f, s_dec = 0.f;
    if (MX == 1) {
      const float c = CUM[tt * 64], cm = CUM[mid * 64], cl = CUM[last * 64];
      s_qm = exps(c - cm); s_km = exps(cm - c); s_qs = exps(c); s_ke = exps(cl - c); s_dec = exps(cl);
    }
    unsigned qm[8], km[8], qs[8];
#pragma unroll
    for (int i = 0; i < 8; ++i) {
      float r_qm[2], r_km[2], r_qs[2];
#pragma unroll
      for (int hh = 0; hh < 2; ++hh) {
        const int k = 2 * i + hh;
        float e_qm, e_km, e_qs, e_ke, e_dec;
        if (MX == 1) { e_qm = s_qm; e_km = s_km; e_qs = s_qs; e_ke = s_ke; e_dec = s_dec; }
        else {
          const float c = CUM[tt * 64 + k0 + k], cm = CUM[mid * 64 + k0 + k], cl = CUM[last * 64 + k0 + k];
          e_qm = exps(c - cm); e_km = exps(cm - c); e_qs = exps(c); e_ke = exps(cl - c); e_dec = (tt == 0) ? exps(cl) : 0.f;
        }
        r_qm[hh] = qv[k] * e_qm;
        r_km[hh] = kin[k] * e_km;
        r_qs[hh] = qv[k] * e_qs;
        const float ke = kin[k] * e_ke;
        const int toff = kvbase + k * 128 + ((t3 ^ ((k >> 1) & 7)) << 4);
        *(bf16_t*)(smem + L_KET + toff) = f2bf(ke);
        *(bf16_t*)(smem + L_VT + toff) = f2bf(vv[k]);
        if (tt == 0) DEC[k0 + k] = e_dec;
      }
      qm[i] = pk2(r_qm[0], r_qm[1]); km[i] = pk2(r_km[0], r_km[1]); qs[i] = pk2(r_qs[0], r_qs[1]);
    }
    if (OUT) {
      *(uint4*)(smem + L_QM + swz(tt, grp * 2)) = make_uint4(qm[0], qm[1], qm[2], qm[3]);
      *(uint4*)(smem + L_QM + swz(tt, grp * 2 + 1)) = make_uint4(qm[4], qm[5], qm[6], qm[7]);
      *(uint4*)(smem + L_KM + swz(tt, grp * 2)) = make_uint4(km[0], km[1], km[2], km[3]);
      *(uint4*)(smem + L_KM + swz(tt, grp * 2 + 1)) = make_uint4(km[4], km[5], km[6], km[7]);
      *(uint4*)(smem + L_QS + swz(tt, grp * 2)) = make_uint4(qs[0], qs[1], qs[2], qs[3]);
      *(uint4*)(smem + L_QS + swz(tt, grp * 2 + 1)) = make_uint4(qs[4], qs[5], qs[6], qs[7]);
    }
  }
  __syncthreads();
  if (OUT) {
    const int t = 16 * w + col;
    bf16_t* MIX = (bf16_t*)(p.ws + WS_HM);
    const size_t orow = (size_t)b * NTOK + T0 + t;
    const int cb = (MX ? 768 : 256) + h * 64;
    const bf16_t* prow = P + orow * PW;
    f32x4 S[4];
#pragma unroll
    for (int a = 0; a < 4; ++a) {
      S[a] = f32x4{0.f, 0.f, 0.f, 0.f};
      const bool need = dir == 0 ? (a <= w) : (a >= w);
      if (need) {
#pragma unroll
        for (int ks = 0; ks < 2; ++ks) {
          const bf16x8 fa = *(const bf16x8*)(smem + L_KM + swz(16 * a + col, ks * 4 + g));
          const bf16x8 fb = *(const bf16x8*)(smem + L_QM + swz(t, ks * 4 + g));
          S[a] = MFMA16(fa, fb, S[a]);
        }
        if (a == w) {
#pragma unroll
          for (int j = 0; j < 4; ++j) { const bool keep = dir == 0 ? (4 * g + j <= col) : (4 * g + j >= col); if (!keep) S[a][j] = 0.f; }
        }
      }
    }
    float den = 0.f;
    if (MX == 1) {
#pragma unroll
      for (int a = 0; a < 4; ++a)
#pragma unroll
        for (int j = 0; j < 4; ++j) den += S[a][j];
      const uint4 q0 = *(const uint4*)(smem + L_QS + swz(t, 2 * g)), q1 = *(const uint4*)(smem + L_QS + swz(t, 2 * g + 1));
      const unsigned qu[8] = {q0.x, q0.y, q0.z, q0.w, q1.x, q1.y, q1.z, q1.w};
#pragma unroll
      for (int i = 0; i < 8; ++i) {
        den += __uint_as_float(qu[i] << 16) * N0[16 * g + 2 * i] + __uint_as_float(qu[i] & 0xffff0000u) * N0[16 * g + 2 * i + 1];
      }
      den += __shfl_xor(den, 16);
      den += __shfl_xor(den, 32);
    }
    f32x4 O[4];
#pragma unroll
    for (int a = 0; a < 4; ++a) O[a] = f32x4{0.f, 0.f, 0.f, 0.f};
#pragma unroll
    for (int kp = 0; kp < 2; ++kp) {
      const bool need = dir == 0 ? (2 * kp <= w) : (2 * kp + 1 >= w);
      if (need) {
        const uint4 u = make_uint4(pk2(S[2 * kp][0], S[2 * kp][1]), pk2(S[2 * kp][2], S[2 * kp][3]), pk2(S[2 * kp + 1][0], S[2 * kp + 1][1]), pk2(S[2 * kp + 1][2], S[2 * kp + 1][3]));
        const bf16x8 pf = __builtin_bit_cast(bf16x8, u);
#pragma unroll
        for (int a = 0; a < 4; ++a) {
          const int vr = 16 * a + col;
          const uint2 lo = *(const uint2*)(smem + L_VT + swz(vr, 4 * kp + (g >> 1)) + (g & 1) * 8);
          const uint2 hi = *(const uint2*)(smem + L_VT + swz(vr, 4 * kp + 2 + (g >> 1)) + (g & 1) * 8);
          const uint4 va = make_uint4(lo.x, lo.y, hi.x, hi.y);
          O[a] = MFMA16(__builtin_bit_cast(bf16x8, va), pf, O[a]);
        }
      }
    }
#pragma unroll
    for (int ks = 0; ks < 2; ++ks) {
      const bf16x8 fb = *(const bf16x8*)(smem + L_QS + swz(t, ks * 4 + g));
#pragma unroll
      for (int a = 0; a < 4; ++a) {
        const bf16x8 fa = *(const bf16x8*)(smem + L_STT + swz(16 * a + col, ks * 4 + g));
        O[a] = MFMA16(fa, fb, O[a]);
      }
    }
    if (MX == 1) {
      const float inv = 1.f / fmaxf(fabsf(den), 1.f);
#pragma unroll
      for (int a = 0; a < 4; ++a)
#pragma unroll
        for (int j = 0; j < 4; ++j) O[a][j] *= inv;
    }
    if (dir == 0) {
#pragma unroll
      for (int a = 0; a < 4; ++a) *(uint2*)(MIX + kblk((int)orow, cb + 16 * a + 4 * g, ROWS)) = make_uint2(pk2(O[a][0], O[a][1]), pk2(O[a][2], O[a][3]));
    } else {
      float ss = 0.f;
#pragma unroll
      for (int a = 0; a < 4; ++a) {
        const uint2 u = *(const uint2*)(MIX + kblk((int)orow, cb + 16 * a + 4 * g, ROWS));
        O[a][0] += __uint_as_float(u.x << 16); O[a][1] += __uint_as_float(u.x & 0xffff0000u);
        O[a][2] += __uint_as_float(u.y << 16); O[a][3] += __uint_as_float(u.y & 0xffff0000u);
#pragma unroll
        for (int j = 0; j < 4; ++j) ss += O[a][j] * O[a][j];
      }
      ss += __shfl_xor(ss, 16);
      ss += __shfl_xor(ss, 32);
      const float rstd = rsqrtf(ss * (1.f / 64.f) + EPS);
      const float* gvec = (MX ? p.ml_g : p.hg_g) + l * 64;
#pragma unroll
      for (int a = 0; a < 4; ++a) {
        const int v0 = 16 * a + 4 * g;
        const uint2 gt = *(const uint2*)(prow + GATE + cb + v0);
        const float4 gg = *(const float4*)(gvec + v0);
        float y0 = O[a][0] * rstd * gg.x * siluf_(__uint_as_float(gt.x << 16));
        float y1 = O[a][1] * rstd * gg.y * siluf_(__uint_as_float(gt.x & 0xffff0000u));
        float y2 = O[a][2] * rstd * gg.z * siluf_(__uint_as_float(gt.y << 16));
        float y3 = O[a][3] * rstd * gg.w * siluf_(__uint_as_float(gt.y & 0xffff0000u));
        if (MX == 1) {
          const uint2 og = *(const uint2*)(prow + D_OG + h * 64 + v0);
          y0 *= sigmoidf_(__uint_as_float(og.x << 16)); y1 *= sigmoidf_(__uint_as_float(og.x & 0xffff0000u));
          y2 *= sigmoidf_(__uint_as_float(og.y << 16)); y3 *= sigmoidf_(__uint_as_float(og.y & 0xffff0000u));
        }
        *(uint2*)(MIX + kblk((int)orow, cb + v0, ROWS)) = make_uint2(pk2(y0, y1), pk2(y2, y3));
      }
    }
  }
  {
#pragma unroll
    for (int c = 0; c < 4; ++c) {
      const float d = DEC[16 * c + col];
#pragma unroll
      for (int j = 0; j < 4; ++j) St[c][j] *= d;
    }
#pragma unroll
    for (int ks = 0; ks < 2; ++ks) {
      const bf16x8 fa = *(const bf16x8*)(smem + L_VT + swz(16 * w + col, ks * 4 + g));
#pragma unroll
      for (int c = 0; c < 4; ++c) {
        const bf16x8 fb = *(const bf16x8*)(smem + L_KET + swz(16 * c + col, ks * 4 + g));
        St[c] = MFMA16(fa, fb, St[c]);
      }
    }
    if (tid < 64) {
      const float d = DEC[tid];
      dtot *= d;
      if (MX == 1) {
        float s = 0.f;
#pragma unroll
        for (int cc = 0; cc < 8; ++cc) {
          const uint4 u = *(const uint4*)(smem + L_KET + swz(tid, cc));
          s += __uint_as_float(u.x << 16) + __uint_as_float(u.x & 0xffff0000u) + __uint_as_float(u.y << 16) + __uint_as_float(u.y & 0xffff0000u)
             + __uint_as_float(u.z << 16) + __uint_as_float(u.z & 0xffff0000u) + __uint_as_float(u.w << 16) + __uint_as_float(u.w & 0xffff0000u);
        }
        nst = d * nst + s;
      }
    }
    __syncthreads();
    if (OUT) {
#pragma unroll
      for (int c = 0; c < 4; ++c)
#pragma unroll
        for (int j = 0; j < 4; ++j) {
          const int v = 16 * w + 4 * g + j, k = 16 * c + col;
          *(bf16_t*)(smem + L_STT + swz(v, k >> 3) + (k & 7) * 2) = f2bf(St[c][j]);
        }
      if (MX == 1 && tid < 64) N0[tid] = nst;
    }
  }
}

DI void rec_setup_lb(const Params& p, int l, int h, unsigned char* smem, int tid) {
  float* LB = (float*)(smem + L_LB);
  __syncthreads();
  if (tid < 64) LB[tid] = (l == 1) ? sigmoidf_(p.hg_lb[256 + h * 64 + tid] - p.hg_lb[h * 64 + tid]) : 0.f;
  __syncthreads();
}

template <int MX>
DI void rec_summary(const Params& p, int l, int b, int h, int dir, int sc, unsigned char* smem) {
  const int tid = ltid_w(p.wave);
  const int lane = tid & 63, w = tid >> 6, col = lane & 15, g = lane >> 4;
  if (MX == 0) rec_setup_lb(p, l, h, smem, tid); else __syncthreads();
  f32x4 St[4];
#pragma unroll
  for (int c = 0; c < 4; ++c) St[c] = f32x4{0.f, 0.f, 0.f, 0.f};
  float nst = 0.f, dtot = 1.f;
  RecRaw raw = rec_load<MX>(p, b, h, dir, sc * 256 + (dir == 0 ? 0 : 3) * 64, tid);
#pragma unroll 1
  for (int ci = 0; ci < 4; ++ci) {
    const int c = dir == 0 ? ci : 3 - ci;
    const int cn = dir == 0 ? (ci < 3 ? ci + 1 : ci) : (ci < 3 ? 2 - ci : 0);
    const RecRaw nxt = rec_load<MX>(p, b, h, dir, sc * 256 + cn * 64, tid);
    rec_chunk<MX, false>(p, l, b, h, dir, sc * 256 + c * 64, smem, St, nst, dtot, tid, raw);
    raw = nxt;
  }
  unsigned char* sp = summ_ptr(p, MX, b, h, dir, sc);
  float* E = (float*)sp;
#pragma unroll
  for (int c = 0; c < 4; ++c)
#pragma unroll
    for (int j = 0; j < 4; ++j) E[(16 * w + 4 * g + j) * 64 + 16 * c + col] = St[c][j];
  if (tid < 64) { ((float*)(sp + 16384))[tid] = dtot; ((float*)(sp + 16640))[tid] = nst; }
}

struct SumRegs { f32x4 E0, E1, E2, E3, d; float nd, nn; };
template <int MX>
DI SumRegs rec_ldsum(const Params& p, int b, int h, int dir, int i, int w, int g, int col, int tid) {
  const int s2 = dir == 0 ? i : (i == 0 ? 0 : 9 - i);
  const unsigned char* sp = summ_ptr(p, MX, b, h, dir, s2);
  const float* E = (const float*)sp + (16 * w + 4 * g) * 64 + col;
  const float* dd = (const float*)(sp + 16384);
  SumRegs r;
  r.d = f32x4{dd[col], dd[16 + col], dd[32 + col], dd[48 + col]};
  r.E0 = f32x4{E[0], E[64], E[128], E[192]};
  r.E1 = f32x4{E[16], E[64 + 16], E[128 + 16], E[192 + 16]};
  r.E2 = f32x4{E[32], E[64 + 32], E[128 + 32], E[192 + 32]};
  r.E3 = f32x4{E[48], E[64 + 48], E[128 + 48], E[192 + 48]};
  r.nd = 0.f; r.nn = 0.f;
  if (MX == 1 && tid < 64) { r.nd = dd[tid]; r.nn = ((const float*)(sp + 16640))[tid]; }
  return r;
}

template <int MX>
DI void rec_output(const Params& p, int l, int b, int h, int sc, unsigned char* smem) {
  const int tid = ltid_w(p.wave);
  const int lane = tid & 63, w = tid >> 6, col = lane & 15, g = lane >> 4;
  if (MX == 0) rec_setup_lb(p, l, h, smem, tid);
#pragma unroll 1
  for (int dir = 0; dir < 2; ++dir) {
    f32x4 St[4];
#pragma unroll
    for (int c = 0; c < 4; ++c) St[c] = f32x4{0.f, 0.f, 0.f, 0.f};
    float nst = 0.f, dtot = 1.f;
    const int npre = dir == 0 ? sc : (sc == 0 ? 0 : 1 + (8 - sc));
    SumRegs cur = rec_ldsum<MX>(p, b, h, dir, 0, w, g, col, tid);
#pragma unroll 1
    for (int i = 0; i < npre; ++i) {
      const SumRegs nxt = rec_ldsum<MX>(p, b, h, dir, (i + 1 < npre) ? i + 1 : i, w, g, col, tid);
      St[0] = cur.d[0] * St[0] + cur.E0;
      St[1] = cur.d[1] * St[1] + cur.E1;
      St[2] = cur.d[2] * St[2] + cur.E2;
      St[3] = cur.d[3] * St[3] + cur.E3;
      if (MX == 1 && tid < 64) nst = cur.nd * nst + cur.nn;
      cur = nxt;
    }
    __syncthreads();
#pragma unroll
    for (int c = 0; c < 4; ++c)
#pragma unroll
      for (int j = 0; j < 4; ++j) {
        const int v = 16 * w + 4 * g + j, k = 16 * c + col;
        *(bf16_t*)(smem + L_STT + swz(v, k >> 3) + (k & 7) * 2) = f2bf(St[c][j]);
      }
    if (MX == 1 && tid < 64) ((float*)(smem + L_N0))[tid] = nst;
    RecRaw raw = rec_load<MX>(p, b, h, dir, sc * 256 + (dir == 0 ? 0 : 3) * 64, tid);
#pragma unroll 1
    for (int ci = 0; ci < 4; ++ci) {
      const int c = dir == 0 ? ci : 3 - ci;
      const int cn = dir == 0 ? (ci < 3 ? ci + 1 : ci) : (ci < 3 ? 2 - ci : 0);
      const RecRaw nxt = rec_load<MX>(p, b, h, dir, sc * 256 + cn * 64, tid);
      rec_chunk<MX, true>(p, l, b, h, dir, sc * 256 + c * 64, smem, St, nst, dtot, tid, raw);
      raw = nxt;
    }
  }
}

typedef __attribute__((address_space(3))) int lds_int;
DI int next_item(unsigned* ctr, volatile lds_int* slot) {
  __syncthreads();
  if (threadIdx.x == 0) *slot = (int)__hip_atomic_fetch_add(ctr, 1u, __ATOMIC_RELAXED, __HIP_MEMORY_SCOPE_AGENT);
  __syncthreads();
  return *slot;
}
DI void ph_mixers1(const Params& p_in, int l, unsigned char* smem, volatile lds_int* slot) {
  const int nfill = (l == 0) ? WT_TILES / 8 : 0;
  const int total = 64 + 1152 + 576 + 576 + nfill;
  unsigned* ctr = (unsigned*)(p_in.ws + WS_CTL + 13824) + (l * 2 + 0);
  for (;;) {
    const int it = next_item(ctr, slot);
    if (it >= total) break;
    Params p = p_in;
    asm volatile("" : "+s"(p.ws));
    if (it < 64) {
      const int mx = it >> 5, h = it & 3, b = (it >> 2) & 7;
      if (l == 0) { if (mx == 0) rec_output<0>(p, l, b, h, 0, smem); else rec_output<1>(p, l, b, h, 0, smem); }
    } else if (it < 1216) { const int r = it - 64; const int qb = r % 36, bh = r / 36; if (!(l == 1 && qb < 4)) attn_mfma<0>(p, l, bh >> 2, bh & 3, qb, smem); }
    else if (it >= 64 + 1152 + 576 + 576) {
      const int f = it - (64 + 1152 + 576 + 576);
      const int tid = ltid_w(p.wave);
      for (int u = 0; u < 8; ++u) wt_tile(p, 1, f * 8 + u, smem, tid);
    } else {
      int r = it - 1216; const int mx = r / 576; r %= 576;
      const int sc = r % 9; r /= 9; const int dir = r & 1, h = (r >> 1) & 3, b = r >> 3;
      const bool last = dir == 0 ? (sc == 8) : (sc == 1);
      if (!last) { if (mx == 0) rec_summary<0>(p, l, b, h, dir, sc, smem); else rec_summary<1>(p, l, b, h, dir, sc, smem); }
    }
  }
}
DI void ph_mixers2(const Params& p_in, int l, unsigned char* smem, volatile lds_int* slot) {
  const int total = 512 + 576;
  unsigned* ctr = (unsigned*)(p_in.ws + WS_CTL + 13824) + (l * 2 + 1);
  for (;;) {
    const int it = next_item(ctr, slot);
    if (it >= total) break;
    Params p = p_in;
    asm volatile("" : "+s"(p.ws));
    if (it < 512) {
      int r = it; const int mx = r >> 8; r &= 255;
      const int sc = 1 + (r & 7); r >>= 3; const int h = r & 3, b = r >> 2;
      if (mx == 0) rec_output<0>(p, l, b, h, sc, smem); else rec_output<1>(p, l, b, h, sc, smem);
    } else { const int r = it - 512; const int qb = r % 18, bh = r / 18; if (!(l == 1 && qb < 2)) attn_mfma<1>(p, l, bh >> 2, bh & 3, qb, smem); }
  }
}

DI void ph_final(const Params& p, int bid, int nb) {
  const int tid_ = ltid_w(p.wave); const int lane = tid_ & 63, w = tid_ >> 6;
  for (int it = bid; it < NB * NLAT / 8; it += nb) {
    float4 v[2][4];
#pragma unroll
    for (int rr = 0; rr < 2; ++rr) {
      const float* rp = p.out + (size_t)(it * 8 + rr * 4 + w) * DM;
#pragma unroll
      for (int i = 0; i < 4; ++i) v[rr][i] = *(const float4*)(rp + (i * 64 + lane) * 4);
    }
#pragma unroll
    for (int rr = 0; rr < 2; ++rr) {
      float* rp = p.out + (size_t)(it * 8 + rr * 4 + w) * DM;
      float ss = 0.f;
#pragma unroll
      for (int i = 0; i < 4; ++i) ss += v[rr][i].x * v[rr][i].x + v[rr][i].y * v[rr][i].y + v[rr][i].z * v[rr][i].z + v[rr][i].w * v[rr][i].w;
      ss = wave_sum(ss);
      const float rstd = rsqrtf(ss * (1.f / DM) + EPS);
#pragma unroll
      for (int i = 0; i < 4; ++i) {
        const int j = (i * 64 + lane) * 4;
        const float4 gg = *(const float4*)(p.final_g + j);
        float4 o;
        o.x = v[rr][i].x * rstd * gg.x; o.y = v[rr][i].y * rstd * gg.y; o.z = v[rr][i].z * rstd * gg.z; o.w = v[rr][i].w * rstd * gg.w;
        *(float4*)(rp + j) = o;
      }
    }
  }
}

constexpr int N_PHASES = 14;
#define XB_TMO      128
#define XB_XCNT(j)  (256  + 64 * (j))
#define XB_XSUB(j)  (1280 + 64 * (j))
#define XB_XGEN(j)  (2304 + 64 * (j))
#define XB_TOP      3328
#define XB_TOPGEN   3392
#define XCD_BAR_WORDS 3456
#define XB_SPIN_CAP (1u << 22)
DI unsigned xb_ld(unsigned* p) { return __hip_atomic_load(p, __ATOMIC_RELAXED, __HIP_MEMORY_SCOPE_AGENT); }
DI unsigned xb_add(unsigned* p, unsigned v) { return __hip_atomic_fetch_add(p, v, __ATOMIC_RELAXED, __HIP_MEMORY_SCOPE_AGENT); }
DI unsigned xb_xcc_id() { return (unsigned)__builtin_amdgcn_s_getreg((3 << 11) | 20) & 0xFu; }
#define XB_SPIN(cond, bar) do { unsigned _sp = 0; while (cond) { __builtin_amdgcn_s_sleep(1); \
    if ((++_sp & 255u) == 0u) { if (xb_ld(&(bar)[XB_TMO])) break; if (_sp > XB_SPIN_CAP) { atomicAdd(&(bar)[XB_TMO], 1u); break; } } } } while (0)
#define LAS __attribute__((address_space(3)))
struct XcdBarrier { unsigned* bar; volatile LAS unsigned* st; };
DI XcdBarrier xcd_barrier_post(unsigned* bar, volatile LAS unsigned* st) {
  XcdBarrier b; b.bar = bar; b.st = st;
  if (threadIdx.x == 0) { const unsigned x = xb_xcc_id(); st[2] = x; (void)xb_add(&bar[XB_XCNT(x)], 1u); }
  return b;
}
DI void xcd_barrier_complete(unsigned* bar, unsigned x, unsigned& nloc, unsigned& nx) {
  const unsigned G = gridDim.x;
  unsigned sum, cnt, mine, sp = 0u;
  for (;;) {
    sum = 0u; cnt = 0u; mine = 0u;
#pragma unroll
    for (unsigned j = 0; j < 16; ++j) { const unsigned c = xb_ld(&bar[XB_XCNT(j)]); sum += c; cnt += (c > 0u) ? 1u : 0u; mine = (j == x) ? c : mine; }
    if (sum == G) break;
    __builtin_amdgcn_s_sleep(1);
    if ((++sp & 255u) == 0u) { if (xb_ld(&bar[XB_TMO])) break; if (sp > XB_SPIN_CAP) { atomicAdd(&bar[XB_TMO], 1u); break; } }
  }
  nloc = mine > 0u ? mine : 1u; nx = cnt > 0u ? cnt : 1u;
}
template <bool FIRST>
DI void xcd_barrier(XcdBarrier& b) {
  asm volatile("s_waitcnt vmcnt(0)" ::: "memory");
  __syncthreads();
  if (threadIdx.x == 0) {
    unsigned* bar = b.bar;
    asm volatile("" : "+s"(bar));
    __builtin_amdgcn_s_waitcnt(0);
    const unsigned bx = b.st[2];
    if (FIRST) { unsigned n0, n1; xcd_barrier_complete(bar, bx, n0, n1); b.st[0] = n0; b.st[1] = n1; }
    const unsigned nloc = b.st[0], nx = b.st[1];
    const unsigned old = xb_add(&bar[XB_XSUB(bx)], 1u);
    const unsigned gen = old / nloc;
    if (old + 1u == (gen + 1u) * nloc) {
      __builtin_amdgcn_fence(__ATOMIC_RELEASE, "agent");
      asm volatile("s_waitcnt vmcnt(0)" ::: "memory");
      const unsigned og = xb_add(&bar[XB_TOP], 1u);
      const unsigned tg = og / nx;
      if (og + 1u == (tg + 1u) * nx) xb_add(&bar[XB_TOPGEN], 1u);
      else XB_SPIN(xb_ld(&bar[XB_TOPGEN]) == tg, bar);
      __builtin_amdgcn_fence(__ATOMIC_ACQUIRE, "agent");
      xb_add(&bar[XB_XGEN(bx)], 1u);
      asm volatile("s_waitcnt vmcnt(0)" ::: "memory");
    } else {
      XB_SPIN(xb_ld(&bar[XB_XGEN(bx)]) == gen, bar);
      __builtin_amdgcn_fence(__ATOMIC_ACQUIRE, "agent");
      asm volatile("s_waitcnt vmcnt(0)" ::: "memory");
    }
  }
  __syncthreads();
}
#ifndef PMASK
#define PMASK 0xff
#endif
#ifndef DUP
#define DUP 0
#endif
#ifndef GWM
#define GWM 4
#endif
__global__ void __launch_bounds__(256, 2) mk_fwd(Params p_in) {
  __shared__ __attribute__((aligned(16))) unsigned char smem[SMEM_BYTES];
  const int bid = blockIdx.x, nb = gridDim.x;
  const int lo = p_in.ph_lo, hi = p_in.ph_hi;
  Params p = p_in;
  p.wave = __builtin_amdgcn_readfirstlane((int)(threadIdx.x >> 6));
#define IN(k) (lo <= (k) && (k) < hi)
#define SEAM(k) do { if (IN(k) && IN((k) + 1)) xcd_barrier<false>(xbar); } while (0)
  __shared__ unsigned xb_words[4];
  __shared__ int q_slot;
  XcdBarrier xbar = xcd_barrier_post((unsigned*)(p.ws + WS_CTL), (volatile LAS unsigned*)&xb_words);
  if (p.ph_lo < 0) cg::this_grid().sync();
  if (IN(0)) { if (PMASK & 1) ph_prep(p, smem, bid, nb); }
  if (IN(0) && IN(1)) xcd_barrier<true>(xbar);
#pragma unroll
  for (int l = 0; l < 2; ++l) {
    const int base = 1 + 6 * l;
    Params q = p;
    asm volatile("" : "+s"(q.ws), "+s"(q.out));
    if (IN(base + 0)) { ph_norm(q, l, bid, nb); if ((DUP & 2) && l == 0) ph_norm(q, l, bid, nb); }
    SEAM(base + 0);
    if (IN(base + 1)) {
      if (PMASK & 2) {
        EpiInM<GWM> e{(bf16_t*)(q.ws + WS_P), (float*)(q.ws + WS_GATES), q.b_in + (size_t)l * PW, (const float2*)(q.ws + WS_ROPE), (const float2*)(q.ws + WS_ROPE) + 64 * 8, (bf16_t*)(q.ws + WS_VTA), (bf16_t*)(q.ws + WS_VTC), smem};
        gemm_mfma<GWM>((const bf16_t*)(q.ws + WS_HM), (const bf16_t*)(q.ws + WS_WINT) + (size_t)l * PWP * DM, ROWS, PWP, ROWS / (GWM * 64), PWP / 128, smem, bid, nb, q.wave, e);
        if ((DUP & 4) && l == 0) gemm_mfma<GWM>((const bf16_t*)(q.ws + WS_HM), (const bf16_t*)(q.ws + WS_WINT) + (size_t)l * PWP * DM, ROWS, PWP, ROWS / (GWM * 64), PWP / 128, smem, bid, nb, q.wave, e);
        if ((DUP & 64) && l == 0) { EpiNull<GWM> en{(float*)(q.ws + WS_CTL + 128)}; gemm_mfma<GWM>((const bf16_t*)(q.ws + WS_HM), (const bf16_t*)(q.ws + WS_WINT) + (size_t)l * PWP * DM, ROWS, PWP, ROWS / (GWM * 64), PWP / 128, smem, bid, nb, q.wave, en); }
      }
    }
    SEAM(base + 1);
    if (IN(base + 2)) { if (PMASK & 4) ph_mixers1(q, l, smem, (volatile lds_int*)&q_slot); if ((DUP & 8) && l == 0) ph_mixers1(q, l, smem, (volatile lds_int*)&q_slot); }
    SEAM(base + 2);
    if (IN(base + 3)) { if (PMASK & 4) ph_mixers2(q, l, smem, (volatile lds_int*)&q_slot); if ((DUP & 16) && l == 0) ph_mixers2(q, l, smem, (volatile lds_int*)&q_slot); }
    SEAM(base + 3);
    if (IN(base + 4) && IN(base + 5)) {}
    if (IN(base + 5)) {
      if (PMASK & 8) {
        EpiOutM<4> e{&q, l, (const float*)(q.ws + WS_MOD), smem, 1};
        gemm_mfma<4>((const bf16_t*)(q.ws + WS_HM), (const bf16_t*)(q.ws + WS_WOUTT) + (size_t)l * DM * DM, ROWS, DM, 64, DM / 128, smem, bid, nb, q.wave, e);
        if (l == 0) {
          EpiOutM<2> e2{&q, l, (const float*)(q.ws + WS_MOD), smem, 2};
          gemm_mfma<2>((const bf16_t*)(q.ws + WS_HM), (const bf16_t*)(q.ws + WS_WOUTT) + (size_t)l * DM * DM, ROWS, DM, 16, DM / 128, smem, bid, nb, q.wave, e2);
        }
      }
    }
    SEAM(base + 5);
  }
  if (IN(13)) ph_final(p, bid, nb);
#undef IN
#undef SEAM
}

extern "C" void kernel_launch(void* const* d_in, const int* in_sizes, int n_in, void* d_out, int out_size, void* d_ws, size_t ws_size, hipStream_t stream) {
  static int grid_blocks = 0;
  if (!grid_blocks) {
    int dev = 0, cus = 0, per_cu = 0;
    hipGetDevice(&dev);
    hipDeviceGetAttribute(&cus, hipDeviceAttributeMultiprocessorCount, dev);
    hipOccupancyMaxActiveBlocksPerMultiprocessor(&per_cu, mk_fwd, 256, 0);
    if (per_cu < 1) per_cu = 1;
    if (per_cu > 4) per_cu = 4;
    grid_blocks = cus * per_cu;
    if (ws_size < WS_END) fprintf(stderr, "kernel_launch: workspace too small: %zu < %zu\n", ws_size, (size_t)WS_END);
  }
  Params p{};
  p.x = (const float*)d_in[0]; p.c = (const float*)d_in[1]; p.ctx = (const float*)d_in[2]; p.c_ctx = (const float*)d_in[3];
  p.w_mod = (const float*)d_in[4]; p.b_mod = (const float*)d_in[5]; p.norm_g = (const float*)d_in[6]; p.w_in = (const float*)d_in[7];
  p.b_in = (const float*)d_in[8]; p.diff_lam = (const float*)d_in[9]; p.diff_g = (const float*)d_in[10]; p.hg_lb = (const float*)d_in[11];
  p.hg_g = (const float*)d_in[12]; p.sw_sink = (const float*)d_in[13]; p.ml_g = (const float*)d_in[14]; p.w_out = (const float*)d_in[15];
  p.final_g = (const float*)d_in[16];
  p.out = (float*)d_out; p.ws = (unsigned char*)d_ws;
#if N_LAUNCH_MODE == 1
  hipMemsetAsync((unsigned char*)d_ws + WS_CTL, 0, 16384, stream);
  p.ph_lo = 0; p.ph_hi = N_PHASES;
  void* args[] = {&p};
  hipError_t e = hipLaunchCooperativeKernel((void*)mk_fwd, dim3(grid_blocks), dim3(256), args, 0, stream);
  if (e != hipSuccess) fprintf(stderr, "cooperative launch failed: %s (grid %d)\n", hipGetErrorString(e), grid_blocks);
#else
  for (int ph = 0; ph < N_PHASES; ++ph) {
    p.ph_lo = ph; p.ph_hi = ph + 1;
    hipLaunchKernelGGL(mk_fwd, dim3(grid_blocks), dim3(256), 0, stream, p);
  }
#endif
}
```
